# Optimizing an MI355X kernel written in HIP

```python
import math
import jax, jax.numpy as jnp
from jax import lax
import numpy as np

D_MODEL = 1024
BATCH = 32
SEQ = 2048
DEPTH = 2

HEAD_DIM = 64
A_Q_HEADS = 8
A_KV_HEADS = 2
A_GROUP = A_Q_HEADS // A_KV_HEADS
WINDOW = 128
BLOCK = 128
B_HEADS = 8
A_WIDTH = A_Q_HEADS * HEAD_DIM
A_KV_WIDTH = A_KV_HEADS * HEAD_DIM
B_WIDTH = B_HEADS * HEAD_DIM
ATTN_WIDTH = A_WIDTH + B_WIDTH
ATTN_SPLITS = (A_WIDTH, A_KV_WIDTH, A_KV_WIDTH, B_WIDTH, B_WIDTH, B_WIDTH, B_HEADS, ATTN_WIDTH)
ATTN_IN = sum(ATTN_SPLITS)
REL_BUCKETS = 32
REL_MAX_EXACT = 16
REL_MAX_DIST = 128
LRU_WIDTH = D_MODEL
LRU_BLOCKS = 8
LRU_BLOCK_W = LRU_WIDTH // LRU_BLOCKS
CONV_WIDTH = 4
LRU_C = 8.0
N_ATTN_LAYERS = (DEPTH + 1) // 2
N_LRU_LAYERS = DEPTH // 2
EPS = 1e-6

kernel_name = "hybrid_swa_fox_rglru_adaln"


def rmsnorm(x, g):
    x32 = x.astype(jnp.float32)
    y = x32 * lax.rsqrt(jnp.mean(x32 * x32, axis=-1, keepdims=True) + EPS)
    return (y * g.astype(jnp.float32)).astype(x.dtype)


def t5_causal_bucket(rel):
    n = jnp.maximum(rel, 0)
    nf = jnp.maximum(n, 1).astype(jnp.float32)
    large = REL_MAX_EXACT + (jnp.log(nf / REL_MAX_EXACT) / math.log(REL_MAX_DIST / REL_MAX_EXACT)
                             * (REL_BUCKETS - REL_MAX_EXACT)).astype(jnp.int32)
    large = jnp.minimum(large, REL_BUCKETS - 1)
    return jnp.where(n < REL_MAX_EXACT, n, large)


def swa_sink_attention(q, k, v, sinks, rel_bias):
    B, S = q.shape[0], q.shape[1]
    nb = S // BLOCK
    qb = q.reshape(B, nb, BLOCK, A_KV_HEADS, A_GROUP, HEAD_DIM)
    pad = ((0, 0), (BLOCK, 0), (0, 0), (0, 0))
    kp = jnp.pad(k, pad)[:, :S].reshape(B, nb, BLOCK, A_KV_HEADS, HEAD_DIM)
    vp = jnp.pad(v, pad)[:, :S].reshape(B, nb, BLOCK, A_KV_HEADS, HEAD_DIM)
    kb = jnp.concatenate([kp, k.reshape(B, nb, BLOCK, A_KV_HEADS, HEAD_DIM)], axis=2)
    vb = jnp.concatenate([vp, v.reshape(B, nb, BLOCK, A_KV_HEADS, HEAD_DIM)], axis=2)
    scores = jnp.einsum('bnqhgd,bnkhd->bhgnqk', qb, kb).astype(jnp.float32) * (HEAD_DIM ** -0.5)
    qi = jnp.arange(BLOCK)[:, None]
    kj = jnp.arange(2 * BLOCK)[None, :]
    rel = qi - kj + BLOCK
    bias = rel_bias.astype(jnp.float32)[t5_causal_bucket(rel)]
    bias = jnp.transpose(bias, (2, 0, 1)).reshape(A_KV_HEADS, A_GROUP, 1, BLOCK, 2 * BLOCK)
    valid = (rel >= 0) & (rel < WINDOW)
    first = (jnp.arange(nb)[:, None, None] == 0) & (kj[None] < BLOCK)
    mask = valid[None] & ~first
    logits = jnp.where(mask, scores + bias, -jnp.inf)
    sink = jnp.broadcast_to(sinks.astype(jnp.float32).reshape(1, A_KV_HEADS, A_GROUP, 1, 1, 1),
                            logits.shape[:-1] + (1,))
    probs = jax.nn.softmax(jnp.concatenate([logits, sink], axis=-1), axis=-1)[..., :-1]
    out = jnp.einsum('bhgnqk,bnkhd->bnqhgd', probs.astype(v.dtype), vb)
    return out.reshape(B, S, A_WIDTH)


def forgetting_attention(q, k, v, log_f):
    B, S = q.shape[0], q.shape[1]
    nb = S // BLOCK
    F = jnp.cumsum(log_f, axis=1)
    outs = []
    for n in range(nb):
        q0, kend = n * BLOCK, (n + 1) * BLOCK
        qs = q[:, q0:kend]
        ks, vs = k[:, :kend], v[:, :kend]
        s = jnp.einsum('bqhd,bkhd->bhqk', qs, ks).astype(jnp.float32) * (HEAD_DIM ** -0.5)
        decay = jnp.transpose(F[:, q0:kend], (0, 2, 1))[..., :, None] - jnp.transpose(F[:, :kend], (0, 2, 1))[..., None, :]
        tpos = q0 + jnp.arange(BLOCK)[:, None]
        spos = jnp.arange(kend)[None, :]
        p = jax.nn.softmax(jnp.where(spos <= tpos, s + decay, -jnp.inf), axis=-1)
        outs.append(jnp.einsum('bhqk,bkhd->bqhd', p.astype(v.dtype), vs))
    return jnp.concatenate(outs, axis=1).reshape(B, S, B_WIDTH)


def attention_mixer(h, w_in, sinks, b_f, w_out, rel_bias):
    B, S, _ = h.shape
    proj = h @ w_in
    idx = np.cumsum(ATTN_SPLITS)[:-1].tolist()
    a_q, a_k, a_v, b_q, b_k, b_v, f_logit, gate = jnp.split(proj, idx, axis=-1)
    a_out = swa_sink_attention(a_q.reshape(B, S, A_Q_HEADS, HEAD_DIM),
                               a_k.reshape(B, S, A_KV_HEADS, HEAD_DIM),
                               a_v.reshape(B, S, A_KV_HEADS, HEAD_DIM), sinks, rel_bias)
    log_f = jax.nn.log_sigmoid((f_logit + b_f).astype(jnp.float32))
    b_out = forgetting_attention(b_q.reshape(B, S, B_HEADS, HEAD_DIM),
                                 b_k.reshape(B, S, B_HEADS, HEAD_DIM),
                                 b_v.reshape(B, S, B_HEADS, HEAD_DIM), log_f)
    y = jnp.concatenate([a_out, b_out], axis=-1) * jax.nn.silu(gate)
    return y @ w_out


def rglru_mixer(h, w_in, conv_w, conv_b, w_a, b_a, w_x, b_x, lam, w_out):
    B, S, _ = h.shape
    proj = h @ w_in
    xr, gate = proj[..., :LRU_WIDTH], proj[..., LRU_WIDTH:]
    xp = jnp.pad(xr, ((0, 0), (CONV_WIDTH - 1, 0), (0, 0)))
    xc = conv_b
    for j in range(CONV_WIDTH):
        xc = xc + xp[:, j:j + S] * conv_w[j]
    xblk = xc.reshape(B, S, LRU_BLOCKS, LRU_BLOCK_W)
    r = jax.nn.sigmoid((jnp.einsum('bsnw,nwv->bsnv', xblk, w_a).reshape(B, S, LRU_WIDTH) + b_a).astype(jnp.float32))
    i = jax.nn.sigmoid((jnp.einsum('bsnw,nwv->bsnv', xblk, w_x).reshape(B, S, LRU_WIDTH) + b_x).astype(jnp.float32))
    log_a = -LRU_C * r * jax.nn.softplus(-lam.astype(jnp.float32))
    a = jnp.exp(log_a)
    u = jnp.sqrt(-jnp.expm1(2.0 * log_a)) * (i * xc.astype(jnp.float32))

    def step(state, inp):
        a_t, u_t = inp
        state = a_t * state + u_t
        return state, state

    _, hs = lax.scan(step, jnp.zeros((B, LRU_WIDTH), jnp.float32),
                     (jnp.transpose(a, (1, 0, 2)), jnp.transpose(u, (1, 0, 2))))
    y = jnp.transpose(hs, (1, 0, 2)).astype(h.dtype) * jax.nn.silu(gate)
    return y @ w_out


def setup_inputs(seed: int = 0) -> dict:
    key = jax.random.key(seed)
    ks = jax.random.split(key, 22)
    nrm = lambda k, shape, s: jax.random.normal(k, shape, jnp.float32) * s
    a0 = jax.random.uniform(ks[19], (N_LRU_LAYERS, LRU_WIDTH), jnp.float32, 0.9, 0.999) ** (1.0 / LRU_C)
    return {
        "x": nrm(ks[0], (BATCH, SEQ, D_MODEL), 1.0),
        "c": nrm(ks[1], (BATCH, D_MODEL), 1.0),
        "rel_bias": nrm(ks[2], (REL_BUCKETS, A_Q_HEADS), 0.2),
        "norm_g": 1.0 + nrm(ks[3], (DEPTH, D_MODEL), 0.05),
        "ada_w": nrm(ks[4], (DEPTH, D_MODEL, 3 * D_MODEL), 0.3 * D_MODEL ** -0.5),
        "ada_b": nrm(ks[5], (DEPTH, 3 * D_MODEL), 0.02),
        "attn_w_in": nrm(ks[6], (N_ATTN_LAYERS, D_MODEL, ATTN_IN), D_MODEL ** -0.5),
        "attn_sinks": nrm(ks[7], (N_ATTN_LAYERS, A_Q_HEADS), 0.5),
        "attn_b_f": jax.random.uniform(ks[8], (N_ATTN_LAYERS, B_HEADS), jnp.float32, 1.0, 4.0),
        "attn_w_out": nrm(ks[9], (N_ATTN_LAYERS, ATTN_WIDTH, D_MODEL), ATTN_WIDTH ** -0.5),
        "lru_w_in": nrm(ks[10], (N_LRU_LAYERS, D_MODEL, 2 * LRU_WIDTH), D_MODEL ** -0.5),
        "lru_conv_w": nrm(ks[11], (N_LRU_LAYERS, CONV_WIDTH, LRU_WIDTH), CONV_WIDTH ** -0.5),
        "lru_conv_b": nrm(ks[12], (N_LRU_LAYERS, LRU_WIDTH), 0.02),
        "lru_w_a": nrm(ks[13], (N_LRU_LAYERS, LRU_BLOCKS, LRU_BLOCK_W, LRU_BLOCK_W), LRU_BLOCK_W ** -0.5),
        "lru_b_a": nrm(ks[14], (N_LRU_LAYERS, LRU_WIDTH), 0.02),
        "lru_w_x": nrm(ks[15], (N_LRU_LAYERS, LRU_BLOCKS, LRU_BLOCK_W, LRU_BLOCK_W), LRU_BLOCK_W ** -0.5),
        "lru_b_x": nrm(ks[16], (N_LRU_LAYERS, LRU_WIDTH), 0.02),
        "lru_lambda": jnp.log(a0) - jnp.log1p(-a0),
        "lru_w_out": nrm(ks[17], (N_LRU_LAYERS, LRU_WIDTH, D_MODEL), LRU_WIDTH ** -0.5),
        "final_g": 1.0 + nrm(ks[18], (D_MODEL,), 0.05),
    }


def reference(x, c, rel_bias, norm_g, ada_w, ada_b, attn_w_in, attn_sinks, attn_b_f, attn_w_out,
              lru_w_in, lru_conv_w, lru_conv_b, lru_w_a, lru_b_a, lru_w_x, lru_b_x, lru_lambda,
              lru_w_out, final_g):
    c_act = jax.nn.silu(c)
    for layer in range(DEPTH):
        mod = c_act @ ada_w[layer] + ada_b[layer]
        shift, scale, gate = jnp.split(mod, 3, axis=-1)
        h = rmsnorm(x, norm_g[layer]) * (1.0 + scale[:, None, :]) + shift[:, None, :]
        if layer % 2 == 0:
            j = layer // 2
            y = attention_mixer(h, attn_w_in[j], attn_sinks[j], attn_b_f[j], attn_w_out[j], rel_bias)
        else:
            j = layer // 2
            y = rglru_mixer(h, lru_w_in[j], lru_conv_w[j], lru_conv_b[j], lru_w_a[j], lru_b_a[j],
                            lru_w_x[j], lru_b_x[j], lru_lambda[j], lru_w_out[j])
        x = x + gate[:, None, :] * y
    return rmsnorm(x, final_g)
```

```cpp
#include <hip/hip_runtime.h>
#include <cstdio>
#include <cstdint>
#include <cmath>
namespace pg8 {
#define PG8_LAS __attribute__((address_space(3)))
typedef unsigned short bf16_t;
typedef short bf16x8 __attribute__((ext_vector_type(8)));
typedef float f32x4 __attribute__((ext_vector_type(4)));
typedef unsigned u32x4 __attribute__((ext_vector_type(4)));
constexpr int BM = 256, BK = 64, HALF = 128, HTB = HALF * BK * 2  , STAGE_BYTES = 8 * HTB, NXCD = 8, WGM = 8;

__host__ __device__ __forceinline__ int lds_byte(int r, int c) { const int st = (r >> 4) * 2 + (c >> 5), rr = r & 15, cc = c & 31, ob = rr * 64 + cc * 2; return st * 1024 + (ob ^ (((ob >> 9) & 1) << 5)); }
__host__ __device__ __forceinline__ void stage_rc(int b, int& R, int& C) { const int st = b / 1024, sb = b % 1024, swz = sb ^ (((sb >> 9) & 1) << 5); R = (st >> 1) * 16 + swz / 64; C = (st & 1) * 32 + (swz % 64) / 2; }
__host__ __device__ __forceinline__ int perm32(int rho) { const int n = rho >> 4, i = rho & 15; return 8 * (i >> 2) + 4 * n + (i & 3); }

struct Unit { int pm, pn; };
struct Gemm { const bf16_t* A; const bf16_t* Bt; int M, N, K; };

struct StaticOrder {
    int nM, nN, nwg, G, c;
    __host__ __device__ void init(int M, int N, int G_, int c_) { nM = M / BM; nN = N / BM; nwg = nM * nN; G = G_; c = c_; }
    __host__ __device__ bool next(int i, Unit& u) const {
        const long L = (long)i * G + c; if (L >= nwg) return false;
        int wgid = (int)L; { const int q = nwg / NXCD, r = nwg % NXCD, xcd = wgid % NXCD, off = wgid / NXCD; wgid = (xcd < r ? xcd * (q + 1) : r * (q + 1) + (xcd - r) * q) + off; }
        const int nig = WGM * nN, gid = wgid / nig, fm = gid * WGM, gsz = (nM - fm) < WGM ? (nM - fm) : WGM;
        u.pm = fm + ((wgid % nig) % gsz); u.pn = (wgid % nig) / gsz; return true;
    }
    __device__ __forceinline__ void a_ready(const Unit&) const {}
    __device__ __forceinline__ void done(const Unit&) const {}
};

__device__ __forceinline__ unsigned cvt_pk_bf16(float lo, float hi) { unsigned r; asm volatile("v_cvt_pk_bf16_f32 %0, %1, %2" : "=v"(r) : "v"(lo), "v"(hi)); return r; }
struct EpiQKVG {
    static constexpr bool PERM = true, AFTER_DRAIN = false;
    bf16_t* O; int ldc; unsigned scale_mask; float sc;
    __device__ __forceinline__ void operator()(const f32x4 (&acc)[2][2][4][2], const Unit& u, int wr, int wc, int fr, int fq) const {
        const float s = ((scale_mask >> u.pn) & 1u) ? sc : 1.f;
        const int row0 = u.pm * BM + wr * 64 + fr, col0 = u.pn * BM + wc * 32 + 8 * fq;
#pragma unroll
        for (int ai = 0; ai < 2; ++ai)
#pragma unroll
            for (int m = 0; m < 4; ++m) { bf16_t* rowp = O + (size_t)(row0 + ai * HALF + m * 16) * ldc + col0;
#pragma unroll
                for (int bj = 0; bj < 2; ++bj) { const f32x4 v0 = acc[ai][bj][m][0] * s, v1 = acc[ai][bj][m][1] * s;
                    u32x4 w; w.x = cvt_pk_bf16(v0[0], v0[1]); w.y = cvt_pk_bf16(v0[2], v0[3]); w.z = cvt_pk_bf16(v1[0], v1[1]); w.w = cvt_pk_bf16(v1[2], v1[3]);
                    *(u32x4*)(rowp + bj * HALF) = w; } }
    }
};
template <bool WITH_A> struct EpiRes {
    static constexpr bool PERM = true, AFTER_DRAIN = false;
    const float* XI; float* XO; bf16_t* AO; const float* gm; int gmp; const float* gs; int gsp; float* part;
    __device__ __forceinline__ void operator()(const f32x4 (&acc)[2][2][4][2], const Unit& u, int wr, int wc, int fr, int fq) const {
        const int b = u.pm >> 3;
        const int col0 = u.pn * BM + wc * 32 + 8 * fq;
        f32x4 gmv[2][2], gsv[2][2];
#pragma unroll
        for (int bj = 0; bj < 2; ++bj)
#pragma unroll
            for (int n = 0; n < 2; ++n) { gmv[bj][n] = *(const f32x4*)(gm + (size_t)b * gmp + col0 + bj * HALF + 4 * n);
                if (WITH_A) gsv[bj][n] = *(const f32x4*)(gs + (size_t)b * gsp + col0 + bj * HALF + 4 * n); }
#pragma unroll
        for (int ai = 0; ai < 2; ++ai)
#pragma unroll
            for (int m = 0; m < 4; ++m) { const int row = u.pm * BM + ai * HALF + wr * 64 + m * 16 + fr; const size_t off = (size_t)row * 1024 + col0;
                float ss = 0.f;
#pragma unroll
                for (int bj = 0; bj < 2; ++bj) {
                    const f32x4 xa = *(const f32x4*)(XI + off + bj * HALF), xb = *(const f32x4*)(XI + off + bj * HALF + 4);
                    const f32x4 o0 = xa + gmv[bj][0] * acc[ai][bj][m][0], o1 = xb + gmv[bj][1] * acc[ai][bj][m][1];
                    *(f32x4*)(XO + off + bj * HALF) = o0; *(f32x4*)(XO + off + bj * HALF + 4) = o1;
                    ss += (o0[0] * o0[0] + o0[1] * o0[1]) + (o0[2] * o0[2] + o0[3] * o0[3]) + (o1[0] * o1[0] + o1[1] * o1[1]) + (o1[2] * o1[2] + o1[3] * o1[3]);
                    if (WITH_A) { const f32x4 a0 = o0 * gsv[bj][0], a1 = o1 * gsv[bj][1];
                        u32x4 w; w.x = cvt_pk_bf16(a0[0], a0[1]); w.y = cvt_pk_bf16(a0[2], a0[3]); w.z = cvt_pk_bf16(a1[0], a1[1]); w.w = cvt_pk_bf16(a1[2], a1[3]);
                        *(u32x4*)(AO + off + bj * HALF) = w; } }
                ss += __shfl_xor(ss, 16); ss += __shfl_xor(ss, 32);
                if (fq == 0) part[(size_t)row * 16 + u.pn * 4 + wc] = ss;
                if (m & 1) asm volatile("" ::: "memory"); }
    }
};
struct EpiXG {
    static constexpr bool PERM = true, AFTER_DRAIN = false;
    bf16_t* O; int ldc; const float* part; const float* sw; int swpitch; float eps;
    __device__ __forceinline__ void operator()(const f32x4 (&acc)[2][2][4][2], const Unit& u, int wr, int wc, int fr, int fq) const {
        const int b = u.pm >> 3;
        const int col0 = u.pn * BM + wc * 32 + 8 * fq;
        f32x4 swv[2][2];
#pragma unroll
        for (int bj = 0; bj < 2; ++bj)
#pragma unroll
            for (int n = 0; n < 2; ++n) swv[bj][n] = *(const f32x4*)(sw + (size_t)b * swpitch + col0 + bj * HALF + 4 * n);
#pragma unroll
        for (int ai = 0; ai < 2; ++ai)
#pragma unroll
            for (int m = 0; m < 4; ++m) { const int row = u.pm * BM + ai * HALF + wr * 64 + m * 16 + fr;
                const f32x4* pp = (const f32x4*)(part + (size_t)row * 16); const f32x4 p0 = pp[0], p1 = pp[1], p2 = pp[2], p3 = pp[3];
                const float ssum = ((p0[0] + p0[1]) + (p0[2] + p0[3])) + ((p1[0] + p1[1]) + (p1[2] + p1[3])) + ((p2[0] + p2[1]) + (p2[2] + p2[3])) + ((p3[0] + p3[1]) + (p3[2] + p3[3]));
                const float rstd = 1.0f / sqrtf(ssum * (1.0f / 1024.0f) + eps);
                bf16_t* rowp = O + (size_t)row * ldc + col0;
#pragma unroll
                for (int bj = 0; bj < 2; ++bj) { const f32x4 v0 = acc[ai][bj][m][0] * rstd + swv[bj][0], v1 = acc[ai][bj][m][1] * rstd + swv[bj][1];
                    u32x4 w; w.x = cvt_pk_bf16(v0[0], v0[1]); w.y = cvt_pk_bf16(v0[2], v0[3]); w.z = cvt_pk_bf16(v1[0], v1[1]); w.w = cvt_pk_bf16(v1[2], v1[3]);
                    *(u32x4*)(rowp + bj * HALF) = w; } }
    }
};
typedef EpiRes<true> EpiRes0; typedef EpiRes<false> EpiRes1;
template <class Epi, class Sched, bool ALIGN_EPI = false, bool SP2 = false>
__device__ __forceinline__ void gemm_phase(PG8_LAS unsigned char* lds, const Gemm g, const Sched& S, const Epi& E) {
    const int tid = threadIdx.x, wid = __builtin_amdgcn_readfirstlane(tid >> 6), lane = tid & 63, wr = wid >> 2, wc = wid & 3, fr = lane & 15, fq = lane >> 4;
    const int K = g.K, nt = K / BK;
    unsigned voffA[2], voffB[2];
#pragma unroll
    for (int i = 0; i < 2; ++i) { int R, C; stage_rc(tid * 16 + i * 8192, R, C); const int Rb = Epi::PERM ? ((R & ~31) + perm32(R & 31)) : R;
        voffA[i] = (unsigned)(R * K + C) * 2u; voffB[i] = (unsigned)(Rb * K + C) * 2u; }
    const size_t kstep = (size_t)(BK * 2);
    const size_t hstep = (size_t)HALF * K * 2;
    const size_t tstep = 2 * hstep;
    const unsigned ldsw = (unsigned)wid * 1024u;
    const int aoff = lds_byte(wr * 64 + fr, fq * 8), boff = lds_byte(wc * 32 + fr, fq * 8);
#define PG8_SA(b, h) (((b) * 2 + (h)) * HTB)
#define PG8_SB(b, h) ((4 + (b) * 2 + (h)) * HTB)
#define PG8_STAGE(bufoff, gbase, voff) do { _Pragma("unroll") for (int _i = 0; _i < 2; ++_i) \
        __builtin_amdgcn_global_load_lds((const unsigned*)((const char*)(gbase) + (voff)[_i]), (PG8_LAS unsigned*)(lds + (bufoff) + ldsw + _i * 8192), 16, 0, 0); } while (0)
#define PG8_LDA(dst, b, h) do { _Pragma("unroll") for (int m = 0; m < 4; ++m) _Pragma("unroll") for (int k = 0; k < 2; ++k) dst[m][k] = *(const PG8_LAS bf16x8*)(lds + PG8_SA(b, h) + aoff + m * 2048 + k * 1024); } while (0)
#define PG8_LDB(dst, b, h) do { _Pragma("unroll") for (int n = 0; n < 2; ++n) _Pragma("unroll") for (int k = 0; k < 2; ++k) dst[n][k] = *(const PG8_LAS bf16x8*)(lds + PG8_SB(b, h) + boff + n * 2048 + k * 1024); } while (0)
#define PG8_MMA(ai, bj, At, Bt) do { __builtin_amdgcn_s_setprio(1); _Pragma("unroll") for (int m = 0; m < 4; ++m) _Pragma("unroll") for (int n = 0; n < 2; ++n) _Pragma("unroll") for (int k = 0; k < 2; ++k) \
        acc[ai][bj][m][n] = __builtin_amdgcn_mfma_f32_16x16x32_bf16(Bt[n][k], At[m][k], acc[ai][bj][m][n], 0, 0, 0); __builtin_amdgcn_s_setprio(0); } while (0)
#define PG8_WAIT_V(n) asm volatile("s_waitcnt vmcnt(" #n ")" ::: "memory")
#define PG8_WAIT_L(n) asm volatile("s_waitcnt lgkmcnt(" #n ")" ::: "memory")
#define PG8_BAR __builtin_amdgcn_s_barrier()
#define PG8_SCHED __builtin_amdgcn_sched_barrier(0)
    Unit cur, nxt; int ui = 0;
    if (!S.next(0, cur)) return;
    f32x4 acc[2][2][4][2];
#pragma unroll
    for (int a = 0; a < 2; ++a)
#pragma unroll
        for (int b = 0; b < 2; ++b)
#pragma unroll
            for (int m = 0; m < 4; ++m)
#pragma unroll
                for (int n = 0; n < 2; ++n) acc[a][b][m][n] = (f32x4){0.f, 0.f, 0.f, 0.f};
    bf16x8 At[4][2], B0[2][2], B1[2][2];
    const char* cA = (const char*)g.A + (size_t)cur.pm * tstep; const char* cB = (const char*)g.Bt + (size_t)cur.pn * tstep;
    S.a_ready(cur);
    if constexpr (SP2) {
        PG8_STAGE(PG8_SB(0, 0), cB, voffB); PG8_STAGE(PG8_SB(0, 1), cB + hstep, voffB); PG8_STAGE(PG8_SA(0, 0), cA, voffA); PG8_STAGE(PG8_SA(0, 1), cA + hstep, voffA);
        if (wr == 1) PG8_BAR;
        PG8_WAIT_V(2); PG8_BAR;
        PG8_STAGE(PG8_SB(1, 0), cB + kstep, voffB); PG8_STAGE(PG8_SA(1, 0), cA + kstep, voffA); PG8_STAGE(PG8_SB(1, 1), cB + hstep + kstep, voffB);
        PG8_WAIT_V(6); PG8_BAR;
    } else {
        PG8_STAGE(PG8_SB(0, 0), cB, voffB); PG8_STAGE(PG8_SA(0, 0), cA, voffA); PG8_STAGE(PG8_SB(0, 1), cB + hstep, voffB); PG8_STAGE(PG8_SA(0, 1), cA + hstep, voffA);
        if (wr == 1) PG8_BAR;
        PG8_WAIT_V(4); PG8_BAR;
        PG8_STAGE(PG8_SB(1, 0), cB + kstep, voffB); PG8_STAGE(PG8_SA(1, 0), cA + kstep, voffA); PG8_STAGE(PG8_SB(1, 1), cB + hstep + kstep, voffB);
        PG8_WAIT_V(6); PG8_BAR;
    }
    for (;;) {
        const bool has_next = S.next(ui + 1, nxt);
        const char* nA = has_next ? (const char*)g.A + (size_t)nxt.pm * tstep : cA; const char* nB = has_next ? (const char*)g.Bt + (size_t)nxt.pn * tstep : cB;
        for (int t = 0; t < nt; t += 2) {
            const bool last = (t == nt - 2);
            const char* a1 = cA + (size_t)(t + 1) * kstep;
            const char* a2 = last ? nA : cA + (size_t)(t + 2) * kstep; const char* b2 = last ? nB : cB + (size_t)(t + 2) * kstep;
            const char* a3 = a2 + kstep; const char* b3 = b2 + kstep;
            if (last && has_next) S.a_ready(nxt);
            if constexpr (SP2) {
            PG8_LDB(B0, 0, 0); PG8_LDB(B1, 0, 1); PG8_SCHED; PG8_LDA(At, 0, 0); PG8_STAGE(PG8_SA(1, 1), a1 + hstep, voffA);
            PG8_WAIT_V(8); PG8_WAIT_L(0); PG8_BAR; PG8_MMA(0, 0, At, B0); PG8_MMA(0, 1, At, B1); PG8_BAR; PG8_SCHED;
            PG8_LDA(At, 0, 1); PG8_STAGE(PG8_SB(0, 0), b2, voffB); PG8_STAGE(PG8_SB(0, 1), b2 + hstep, voffB); PG8_STAGE(PG8_SA(0, 0), a2, voffA);
            PG8_WAIT_V(8); PG8_WAIT_L(0); PG8_BAR; PG8_MMA(1, 0, At, B0); PG8_MMA(1, 1, At, B1); PG8_BAR; PG8_SCHED;
            PG8_LDB(B0, 1, 0); PG8_LDB(B1, 1, 1); PG8_SCHED; PG8_LDA(At, 1, 0); PG8_STAGE(PG8_SA(0, 1), a2 + hstep, voffA);
            PG8_WAIT_V(8); PG8_WAIT_L(0); PG8_BAR; PG8_MMA(0, 0, At, B0); PG8_MMA(0, 1, At, B1); PG8_BAR; PG8_SCHED;
            PG8_LDA(At, 1, 1); PG8_STAGE(PG8_SB(1, 0), b3, voffB); PG8_STAGE(PG8_SB(1, 1), b3 + hstep, voffB); PG8_STAGE(PG8_SA(1, 0), a3, voffA);
            PG8_WAIT_V(8); PG8_WAIT_L(0); PG8_BAR; PG8_MMA(1, 0, At, B0); PG8_MMA(1, 1, At, B1); PG8_BAR; PG8_SCHED;
            } else {
            PG8_LDB(B0, 0, 0); PG8_SCHED; PG8_LDA(At, 0, 0); PG8_STAGE(PG8_SA(1, 1), a1 + hstep, voffA);
            PG8_WAIT_L(8); PG8_BAR; PG8_WAIT_L(0); PG8_MMA(0, 0, At, B0); PG8_BAR; PG8_SCHED;
            PG8_LDB(B1, 0, 1); PG8_STAGE(PG8_SB(0, 0), b2, voffB);
            PG8_BAR; PG8_WAIT_L(0); PG8_MMA(0, 1, At, B1); PG8_BAR;
            PG8_LDA(At, 0, 1); PG8_STAGE(PG8_SA(0, 0), a2, voffA);
            PG8_BAR; PG8_WAIT_L(0); PG8_MMA(1, 0, At, B0); PG8_BAR; PG8_SCHED;
            PG8_STAGE(PG8_SB(0, 1), b2 + hstep, voffB);
            PG8_WAIT_V(6); PG8_BAR; PG8_MMA(1, 1, At, B1); PG8_BAR;
            PG8_LDB(B0, 1, 0); PG8_SCHED; PG8_LDA(At, 1, 0); PG8_STAGE(PG8_SA(0, 1), a2 + hstep, voffA);
            PG8_WAIT_L(8); PG8_BAR; PG8_WAIT_L(0); PG8_MMA(0, 0, At, B0); PG8_BAR; PG8_SCHED;
            PG8_LDB(B1, 1, 1); PG8_STAGE(PG8_SB(1, 0), b3, voffB);
            PG8_BAR; PG8_WAIT_L(0); PG8_MMA(0, 1, At, B1); PG8_BAR;
            PG8_LDA(At, 1, 1); PG8_STAGE(PG8_SA(1, 0), a3, voffA);
            PG8_BAR; PG8_WAIT_L(0); PG8_MMA(1, 0, At, B0); PG8_BAR; PG8_SCHED;
            PG8_STAGE(PG8_SB(1, 1), b3 + hstep, voffB);
            PG8_WAIT_V(6); PG8_BAR; PG8_MMA(1, 1, At, B1); PG8_BAR;
            }
        }
        if constexpr (ALIGN_EPI) { if (wr == 0) PG8_BAR; }
        if constexpr (!Epi::AFTER_DRAIN) { E(acc, cur, wr, wc, fr, fq); S.done(cur); }
        if (!has_next) break;
#pragma unroll
        for (int a = 0; a < 2; ++a)
#pragma unroll
            for (int b = 0; b < 2; ++b)
#pragma unroll
                for (int m = 0; m < 4; ++m)
#pragma unroll
                    for (int n = 0; n < 2; ++n) acc[a][b][m][n] = (f32x4){0.f, 0.f, 0.f, 0.f};
        cur = nxt; cA = nA; cB = nB; ++ui;
        if constexpr (ALIGN_EPI) { if (wr == 1) PG8_BAR; }
    }
    PG8_WAIT_V(0);
    if constexpr (!ALIGN_EPI) { if (wr == 0) PG8_BAR; }
    PG8_BAR;
    if constexpr (Epi::AFTER_DRAIN) { E.fused(acc, cur, wr, wc, fr, fq, lds, wid, lane); S.done(cur); }
#undef PG8_SA
#undef PG8_SB
#undef PG8_STAGE
#undef PG8_LDA
#undef PG8_LDB
#undef PG8_MMA
#undef PG8_WAIT_V
#undef PG8_WAIT_L
#undef PG8_BAR
#undef PG8_SCHED
}
}

constexpr int NWAVES = 8;
#ifndef MK_N_LAUNCHES
#define MK_N_LAUNCHES 1
#endif
constexpr int N_PHASES = 9;
constexpr int N_LAUNCHES = MK_N_LAUNCHES;
#ifndef GEMM_NAIVE
#define GEMM_NAIVE 0
#endif
#ifndef P2_NAIVE
#define P2_NAIVE 1
#endif
#ifndef P5_NAIVE
#define P5_NAIVE 1
#endif

constexpr int BATCH = 32, SEQ = 2048, D = 1024, M = BATCH * SEQ;
constexpr int HD = 64, AQH = 8, AKVH = 2, BH = 8, WINDOW = 128;
constexpr int ATTN_IN = 3336, NQ = 3328;
constexpr int C_AQ = 0, C_AK = 512, C_AV = 640, C_BQ = 768, C_BK = 1280, C_BV = 1792, C_G = 2304;
constexpr int LRU_W = 1024, NXG = 2048;
constexpr float EPS = 1e-6f, LOG2E = 1.4426950408889634f, QSCALE = 0.125f * 1.4426950408889634f;

constexpr size_t MiB = 1u << 20;
constexpr size_t WS_CTL = 0, CTL_ZERO_BYTES = 1 * MiB;
constexpr size_t WS_MOD = 1 * MiB;
constexpr size_t WS_GS = WS_MOD + 768 * 1024;
constexpr size_t WS_SW1 = 2 * MiB;
constexpr size_t WS_PART = 3 * MiB, WS_PART2 = 7 * MiB;
constexpr size_t WS_LF = 11 * MiB;
constexpr size_t WS_W0T = 16 * MiB, WS_WO0T = 23 * MiB, WS_W1T = 25 * MiB, WS_WO1T = 29 * MiB, WS_WAT = 31 * MiB, WS_WXT = WS_WAT + 256 * 1024;
constexpr size_t WS_R2 = 32 * MiB;
constexpr size_t WS_X1 = 160 * MiB;
constexpr size_t WS_R1 = 416 * MiB;
constexpr size_t WS_A1 = WS_R1, WS_XG = WS_R1 + 128 * MiB;
constexpr size_t WS_END = 832 * MiB;
static_assert(WS_W0T + (size_t)NQ * D * 2 <= WS_WO0T && WS_XG + (size_t)M * NXG * 2 <= WS_END && WS_R1 + (size_t)M * NQ * 2 <= WS_END, "ws map");
constexpr int CW_BAR = 4096;

constexpr int RING_OFF = 0, RING_BYTES = 131072;
constexpr int LDSCTL_OFF = RING_BYTES, MISC_OFF = LDSCTL_OFF + 320;
constexpr int LDS_BYTES = 147456;

#define GAS __attribute__((address_space(1)))
#define LAS __attribute__((address_space(3)))
typedef unsigned short bf16;
typedef unsigned v4u __attribute__((ext_vector_type(4)));
typedef unsigned v2u __attribute__((ext_vector_type(2)));
typedef float f32x4 __attribute__((ext_vector_type(4)));
typedef short bf16x8 __attribute__((ext_vector_type(8)));
typedef GAS unsigned gu32;
#define RLX_AGENT __ATOMIC_RELAXED, __HIP_MEMORY_SCOPE_AGENT
#define LDS_WAIT() asm volatile("s_waitcnt lgkmcnt(0)" ::: "memory")
#define VM_WAIT() asm volatile("s_waitcnt vmcnt(0)" ::: "memory")
__device__ __forceinline__ unsigned f2bf(float f) { unsigned u = __builtin_bit_cast(unsigned, f); return (u + 0x7fffu + ((u >> 16) & 1u)) >> 16; }
__device__ __forceinline__ unsigned pk2(float lo, float hi) { return f2bf(lo) | (f2bf(hi) << 16); }
__device__ __forceinline__ float bf2f(unsigned short h) { return __builtin_bit_cast(float, (unsigned)h << 16); }
__device__ __forceinline__ float bflo(unsigned w) { return __builtin_bit_cast(float, w << 16); }
__device__ __forceinline__ float bfhi(unsigned w) { return __builtin_bit_cast(float, w & 0xffff0000u); }
__device__ __forceinline__ float sigmoidf_(float x) { return 1.0f / (1.0f + __expf(-x)); }
#define XB_TMO      128
#define XB_XCNT(j)  (256  + 64 * (j))
#define XB_XSUB(j)  (1280 + 64 * (j))
#define XB_XGEN(j)  (2304 + 64 * (j))
#define XB_TOP      3328
#define XB_TOPGEN   3392
#define XCD_BAR_WORDS 3456
#define XB_SPIN_CAP (1u << 18)

__device__ __forceinline__ unsigned xb_ld(unsigned* p)              { return __hip_atomic_load(p, __ATOMIC_RELAXED, __HIP_MEMORY_SCOPE_AGENT); }
__device__ __forceinline__ unsigned xb_add(unsigned* p, unsigned v) { return __hip_atomic_fetch_add(p, v, __ATOMIC_RELAXED, __HIP_MEMORY_SCOPE_AGENT); }
__device__ __forceinline__ unsigned xb_xcc_id() { return (unsigned)__builtin_amdgcn_s_getreg((3 << 11) | 20) & 0xFu; }
#define XB_SPIN(cond, bar) do { unsigned _sp = 0; while (cond) { __builtin_amdgcn_s_sleep(1); \
    if ((++_sp & 255u) == 0u) { if (xb_ld(&(bar)[XB_TMO])) break; if (_sp > XB_SPIN_CAP) { atomicAdd(&(bar)[XB_TMO], 1u); break; } } } } while (0)

struct XcdBarrier {
    unsigned* bar; unsigned x;
    volatile LAS unsigned* st;
};

__device__ __forceinline__ XcdBarrier xcd_barrier_post(unsigned* bar, volatile LAS unsigned* st) {
    XcdBarrier b; b.bar = bar; b.x = xb_xcc_id(); b.st = st;
    if (threadIdx.x == 0) (void)xb_add(&bar[XB_XCNT(b.x)], 1u);
    return b;
}
__device__ __forceinline__ void xcd_barrier_complete(unsigned* bar, unsigned x, unsigned& nloc, unsigned& nx) {
    const unsigned G = gridDim.x * gridDim.y * gridDim.z;
    unsigned sum, cnt, mine, sp = 0u;
    for (;;) {
        sum = 0u; cnt = 0u; mine = 0u;
#pragma unroll
        for (unsigned j = 0; j < 16; ++j) { const unsigned c = xb_ld(&bar[XB_XCNT(j)]); sum += c; cnt += (c > 0u) ? 1u : 0u; mine = (j == x) ? c : mine; }
        if (sum == G) break;
        __builtin_amdgcn_s_sleep(1);
        if ((++sp & 255u) == 0u) { if (xb_ld(&bar[XB_TMO])) break; if (sp > XB_SPIN_CAP) { atomicAdd(&bar[XB_TMO], 1u); break; } }
    }
    nloc = mine > 0u ? mine : 1u; nx = cnt > 0u ? cnt : 1u;
}

__device__ __forceinline__ void xcd_barrier(const XcdBarrier& b) {
    asm volatile("s_waitcnt vmcnt(0)" ::: "memory");
    __syncthreads();
    if (threadIdx.x == 0) {
        unsigned* bar = b.bar;
        __builtin_amdgcn_s_waitcnt(0);
        unsigned nloc = b.st[0], nx = b.st[1];
        if (nloc == 0u) { xcd_barrier_complete(bar, b.x, nloc, nx); b.st[0] = nloc; b.st[1] = nx; }
        const unsigned old = xb_add(&bar[XB_XSUB(b.x)], 1u);
        const unsigned gen = old / nloc;
        if (old + 1u == (gen + 1u) * nloc) {
            __builtin_amdgcn_fence(__ATOMIC_RELEASE, "agent");
            asm volatile("s_waitcnt vmcnt(0)" ::: "memory");
            const unsigned og = xb_add(&bar[XB_TOP], 1u);
            const unsigned tg = og / nx;
            if (og + 1u == (tg + 1u) * nx) xb_add(&bar[XB_TOPGEN], 1u);
            else XB_SPIN(xb_ld(&bar[XB_TOPGEN]) == tg, bar);
            __builtin_amdgcn_fence(__ATOMIC_ACQUIRE, "agent");
            xb_add(&bar[XB_XGEN(b.x)], 1u);
            asm volatile("s_waitcnt vmcnt(0)" ::: "memory");
        } else {
            XB_SPIN(xb_ld(&bar[XB_XGEN(b.x)]) == gen, bar);
            __builtin_amdgcn_fence(__ATOMIC_ACQUIRE, "agent");
            asm volatile("s_waitcnt vmcnt(0)" ::: "memory");
        }
    }
    __syncthreads();
}

struct Frame {
    LAS unsigned char* lds;
    volatile LAS unsigned* MISC;
    gu32* ctl;
    int tid, lane, wave;
    int vcu, G;
    const float *x, *c, *rel_bias, *norm_g, *ada_w, *ada_b, *attn_w_in, *attn_sinks, *attn_b_f, *attn_w_out, *lru_w_in, *lru_conv_w, *lru_conv_b, *lru_w_a, *lru_b_a, *lru_w_x, *lru_b_x, *lru_lambda, *lru_w_out, *final_g;
    float* out;
    float *mod, *gs, *sw1, *part, *part2, *lf, *x1;
    bf16 *W0T, *WO0T, *W1T, *WO1T, *WAT, *WXT, *R2, *QKVG, *A1, *XG;
};
__device__ __forceinline__ float wave_sum(float v) {
#pragma unroll
    for (int o = 1; o < 64; o <<= 1) v += __shfl_xor(v, o);
    return v;
}

__device__ __forceinline__ void p0_transpose_item(const float* W, int pitch, int K, int ncols, bf16* WT, LAS float* scr, int item, int lane) {
    const int nblk = ncols / 32, kb = item / nblk, nb = item % nblk, k0 = 64 * kb, n0 = 32 * nb;
#pragma unroll 8
    for (int i = 0; i < 32; ++i) { const int kk = 2 * i + (lane >> 5); scr[kk * 33 + (lane & 31)] = W[(size_t)(k0 + kk) * pitch + n0 + (lane & 31)]; }
    LDS_WAIT(); asm volatile("" ::: "memory");
    const int c = lane & 7;
#pragma unroll
    for (int j = 0; j < 4; ++j) { const int n = (lane >> 3) + 8 * j; const LAS float* s = scr + (8 * c) * 33 + n;
        v4u o; o.x = pk2(s[0 * 33], s[1 * 33]); o.y = pk2(s[2 * 33], s[3 * 33]); o.z = pk2(s[4 * 33], s[5 * 33]); o.w = pk2(s[6 * 33], s[7 * 33]);
        *(GAS v4u*)(WT + (size_t)(n0 + n) * K + k0 + 8 * c) = o; }
    LDS_WAIT(); asm volatile("" ::: "memory");
}
__device__ __forceinline__ void sg_stage(LAS float* sIn, const float* in, int in_pitch, bool act, int tid) {
    for (int idx = tid; idx < 32 * 1024; idx += NWAVES * 64) { const int k = idx >> 5, b = idx & 31; float v = in[(size_t)b * in_pitch + k]; if (act) v = v * sigmoidf_(v); sIn[idx] = v; }
    __syncthreads();
}
__device__ __forceinline__ void sg_block(LAS float* ring, const float* W, int wp, int col0, const float* bias, float* out, int out_pitch, int tid, int lane, int wave) {
    float acc[32];
#pragma unroll
    for (int b = 0; b < 32; ++b) acc[b] = 0.f;
    const float* wptr = W + (size_t)((tid >> 5) * 64) * wp + col0 + (tid & 31);
#pragma unroll 4
    for (int kk = 0; kk < 64; ++kk) { const float w = wptr[(size_t)kk * wp]; const LAS f32x4* s = (const LAS f32x4*)(ring + ((tid >> 5) * 64 + kk) * 32);
#pragma unroll
        for (int q = 0; q < 8; ++q) { const f32x4 v = s[q]; acc[4 * q] += w * v[0]; acc[4 * q + 1] += w * v[1]; acc[4 * q + 2] += w * v[2]; acc[4 * q + 3] += w * v[3]; } }
#pragma unroll
    for (int b = 0; b < 32; ++b) acc[b] += __shfl_xor(acc[b], 32);
    __syncthreads();
    if (lane < 32) {
#pragma unroll
        for (int b = 0; b < 32; ++b) ring[(wave * 32 + b) * 32 + lane] = acc[b];
    }
    __syncthreads();
#pragma unroll
    for (int h = 0; h < 2; ++h) { const int o = tid + h * 512, b = o >> 5, c2 = o & 31; float s = bias ? bias[col0 + c2] : 0.f;
#pragma unroll
        for (int g = 0; g < 8; ++g) s += ring[(g * 32 + b) * 32 + c2];
        out[(size_t)b * out_pitch + col0 + c2] = s; }
    __syncthreads();
}

__device__ __forceinline__ void p0a(Frame& F) {
    LAS float* ring = (LAS float*)(F.lds + RING_OFF);
    for (int it = F.vcu; it < 192; it += F.G) {
        sg_stage(ring, F.c, D, true, F.tid);
        const int l = it / 96, cb = it % 96;
        sg_block(ring, F.ada_w + (size_t)l * D * 3072, 3072, cb * 32, F.ada_b + l * 3072, F.mod + (size_t)l * 32 * 3072, 3072, F.tid, F.lane, F.wave);
    }
    LAS float* scr = (LAS float*)(F.lds + RING_OFF + F.wave * 16384);
    const int gw = F.vcu * NWAVES + F.wave, NGW = F.G * NWAVES;
    constexpr int I_W0A = (D / 64) * (2304 / 32), I_W0B = (D / 64) * (1024 / 32), I_SQ = (D / 64) * (D / 32), I_W1 = (D / 64) * (2048 / 32), I_G = (128 / 64) * (128 / 32);
    constexpr int NITEMS = I_W0A + I_W0B + I_SQ + I_W1 + I_SQ + 16 * I_G;
    for (int it = gw; it < NITEMS; it += NGW) {
        int r = it;
        if (r < I_W0A) { p0_transpose_item(F.attn_w_in, ATTN_IN, D, 2304, F.W0T, scr, r, F.lane); continue; } r -= I_W0A;
        if (r < I_W0B) { p0_transpose_item(F.attn_w_in + 2312, ATTN_IN, D, 1024, F.W0T + (size_t)2304 * D, scr, r, F.lane); continue; } r -= I_W0B;
        if (r < I_SQ) { p0_transpose_item(F.attn_w_out, D, D, D, F.WO0T, scr, r, F.lane); continue; } r -= I_SQ;
        if (r < I_W1) { p0_transpose_item(F.lru_w_in, 2048, D, 2048, F.W1T, scr, r, F.lane); continue; } r -= I_W1;
        if (r < I_SQ) { p0_transpose_item(F.lru_w_out, D, D, D, F.WO1T, scr, r, F.lane); continue; } r -= I_SQ;
        { const int mtx = r / I_G, item = r % I_G; const int n = mtx & 7;
          if (mtx < 8) p0_transpose_item(F.lru_w_a + (size_t)n * 16384, 128, 128, 128, F.WAT + (size_t)n * 16384, scr, item, F.lane);
          else         p0_transpose_item(F.lru_w_x + (size_t)n * 16384, 128, 128, 128, F.WXT + (size_t)n * 16384, scr, item, F.lane); }
    }
}

__device__ __forceinline__ void p0b(Frame& F) {
    LAS float* ring = (LAS float*)(F.lds + RING_OFF);
    for (int idx = F.vcu * 512 + F.tid; idx < 2 * 32 * 1024; idx += F.G * 512) { const int k = idx & 1023, lb = idx >> 10, l = lb >> 5;
        F.gs[idx] = F.norm_g[l * 1024 + k] * (1.0f + F.mod[(size_t)lb * 3072 + 1024 + k]); }
    for (int it = F.vcu; it < 64; it += F.G) {
        sg_stage(ring, F.mod + (size_t)32 * 3072, 3072, false, F.tid);
        sg_block(ring, F.lru_w_in, 2048, it * 32, nullptr, F.sw1, 2048, F.tid, F.lane, F.wave);
    }
    const int gw = F.vcu * NWAVES + F.wave, NGW = F.G * NWAVES;
    for (int ch = gw; ch < M / 32; ch += NGW) {
        const int b = ch >> 6;
        f32x4 gsv[4], shv[4], wf[16][2];
#pragma unroll
        for (int j = 0; j < 4; ++j) { const int k = 4 * F.lane + 256 * j;
            const f32x4 g = *(const f32x4*)(F.norm_g + k), sc = *(const f32x4*)(F.mod + (size_t)b * 3072 + 1024 + k);
            gsv[j] = g * (1.0f + sc); shv[j] = *(const f32x4*)(F.mod + (size_t)b * 3072 + k);
#pragma unroll
            for (int e = 0; e < 4; ++e) { const float* wp = F.attn_w_in + (size_t)(k + e) * ATTN_IN + 2304; wf[4 * j + e][0] = *(const f32x4*)wp; wf[4 * j + e][1] = *(const f32x4*)(wp + 4); } }
        const float bf_mine = F.attn_b_f[F.lane & 7];
        for (int r = 0; r < 32; ++r) {
            const int m = ch * 32 + r;
            const GAS f32x4* xr = (const GAS f32x4*)(F.x + (size_t)m * D) + F.lane;
            f32x4 v[4]; float ss = 0.f;
#pragma unroll
            for (int j = 0; j < 4; ++j) { v[j] = xr[64 * j]; ss += (v[j][0] * v[j][0] + v[j][1] * v[j][1]) + (v[j][2] * v[j][2] + v[j][3] * v[j][3]); }
            const float rstd = 1.0f / sqrtf(wave_sum(ss) * (1.0f / D) + EPS);
            float p[8];
#pragma unroll
            for (int q = 0; q < 8; ++q) p[q] = 0.f;
            GAS unsigned long long* o8 = (GAS unsigned long long*)(F.R2 + (size_t)m * D) + F.lane;
#pragma unroll
            for (int j = 0; j < 4; ++j) { const f32x4 h = v[j] * rstd * gsv[j] + shv[j];
                o8[64 * j] = (unsigned long long)pk2(h[0], h[1]) | ((unsigned long long)pk2(h[2], h[3]) << 32);
#pragma unroll
                for (int e = 0; e < 4; ++e) {
#pragma unroll
                    for (int q = 0; q < 4; ++q) { p[q] += h[e] * wf[4 * j + e][0][q]; p[4 + q] += h[e] * wf[4 * j + e][1][q]; } } }
#pragma unroll
            for (int q = 0; q < 8; ++q) p[q] = wave_sum(p[q]);
            float z = p[0];
#pragma unroll
            for (int q = 1; q < 8; ++q) z = ((F.lane & 7) == q) ? p[q] : z;
            z += bf_mine;
            const float lfv = fminf(z, 0.f) - log1pf(expf(-fabsf(z)));
            if (F.lane < 8) F.lf[(size_t)m * 8 + F.lane] = lfv;
        }
    }
}

__device__ __forceinline__ void p7(Frame& F) {
    const int gw = F.vcu * NWAVES + F.wave, NGW = F.G * NWAVES;
    f32x4 g[4];
#pragma unroll
    for (int j = 0; j < 4; ++j) g[j] = *(const f32x4*)(F.final_g + 4 * F.lane + 256 * j);
    for (int m = gw; m < M; m += NGW) {
        const float pv = F.part2[(size_t)m * 16 + (F.lane & 15)];
        float s = pv; s += __shfl_xor(s, 1); s += __shfl_xor(s, 2); s += __shfl_xor(s, 4); s += __shfl_xor(s, 8);
        const float rstd = 1.0f / sqrtf(s * (1.0f / D) + EPS);
        GAS f32x4* o = (GAS f32x4*)(F.out + (size_t)m * D) + F.lane;
#pragma unroll
        for (int j = 0; j < 4; ++j) { f32x4 v = o[64 * j]; o[64 * j] = v * rstd * g[j]; }
    }
}

__device__ __forceinline__ int t5_bucket(int rel) {
    if (rel < 16) return rel;
    const float v = logf((float)rel / 16.0f) / logf(8.0f) * 16.0f;
    int l = 16 + (int)v; return l < 31 ? l : 31;
}
__device__ __forceinline__ void block_cumsum_2048(const float* src, int stride, LAS float* sF, LAS float* sTmp, int tid, int lane, int wave) {
    float v0 = src[(size_t)(4 * tid + 0) * stride], v1 = src[(size_t)(4 * tid + 1) * stride], v2 = src[(size_t)(4 * tid + 2) * stride], v3 = src[(size_t)(4 * tid + 3) * stride];
    v1 += v0; v2 += v1; v3 += v2;
    float s = v3;
#pragma unroll
    for (int o = 1; o < 64; o <<= 1) { const float t = __shfl_up(s, o); if (lane >= o) s += t; }
    if (lane == 63) sTmp[wave] = s;
    __syncthreads();
    float base = s - v3;
    for (int w = 0; w < wave; ++w) base += sTmp[w];
    sF[4 * tid + 0] = base + v0; sF[4 * tid + 1] = base + v1; sF[4 * tid + 2] = base + v2; sF[4 * tid + 3] = base + v3;
    __syncthreads();
}
__device__ __forceinline__ void p2_naive(Frame& F) {
    LAS float* sF = (LAS float*)(F.lds + RING_OFF);
    LAS float* sTmp = sF + 2048;
    LAS float* sB = sF + 2048 + 64;
    const int tid = F.tid;
    for (int bh = F.vcu; bh < BATCH * BH; bh += F.G) {
        const int b = bh >> 3, h = bh & 7;
        block_cumsum_2048(F.lf + (size_t)b * SEQ * 8 + h, 8, sF, sTmp, tid, F.lane, F.wave);
        for (int it = 0; it < 4; ++it) {
            const int t = it * 512 + tid; const size_t m = (size_t)b * SEQ + t;
            float q[64], o[64];
            const bf16* qp = F.QKVG + m * NQ + C_BQ + 64 * h;
#pragma unroll
            for (int d = 0; d < 64; ++d) { q[d] = bf2f(qp[d]); o[d] = 0.f; }
            const float Ft = sF[t] * LOG2E;
            float mx = -INFINITY, l = 0.f;
            const int tmax = it * 512 + (tid | 63);
            for (int s = 0; s <= tmax; ++s) {
                const bf16* kp = F.QKVG + ((size_t)b * SEQ + s) * NQ + C_BK + 64 * h; const bf16* vp = kp + (C_BV - C_BK);
                float dot = 0.f;
#pragma unroll
                for (int d8 = 0; d8 < 8; ++d8) { const v4u kk = *(const v4u*)(kp + 8 * d8);
                    dot += q[8 * d8 + 0] * bflo(kk.x) + q[8 * d8 + 1] * bfhi(kk.x) + q[8 * d8 + 2] * bflo(kk.y) + q[8 * d8 + 3] * bfhi(kk.y)
                         + q[8 * d8 + 4] * bflo(kk.z) + q[8 * d8 + 5] * bfhi(kk.z) + q[8 * d8 + 6] * bflo(kk.w) + q[8 * d8 + 7] * bfhi(kk.w); }
                const float logit = dot + Ft - sF[s] * LOG2E;
                if (s <= t) {
                    if (logit > mx) { const float f = exp2f(mx - logit); l *= f;
#pragma unroll
                        for (int d = 0; d < 64; ++d) o[d] *= f;
                        mx = logit; }
                    const float p = exp2f(logit - mx); l += p;
#pragma unroll
                    for (int d8 = 0; d8 < 8; ++d8) { const v4u vv = *(const v4u*)(vp + 8 * d8);
                        o[8 * d8 + 0] += p * bflo(vv.x); o[8 * d8 + 1] += p * bfhi(vv.x); o[8 * d8 + 2] += p * bflo(vv.y); o[8 * d8 + 3] += p * bfhi(vv.y);
                        o[8 * d8 + 4] += p * bflo(vv.z); o[8 * d8 + 5] += p * bfhi(vv.z); o[8 * d8 + 6] += p * bflo(vv.w); o[8 * d8 + 7] += p * bfhi(vv.w); }
                }
            }
            const float rl = 1.0f / l;
            const bf16* gp = F.QKVG + m * NQ + C_G + 512 + 64 * h; bf16* yp = F.R2 + m * D + 512 + 64 * h;
#pragma unroll
            for (int d = 0; d < 64; ++d) { const float g = bf2f(gp[d]); yp[d] = (bf16)f2bf(o[d] * rl * g * sigmoidf_(g)); }
        }
        __syncthreads();
    }
    for (int it0 = F.vcu; it0 < BATCH * AKVH * 4; it0 += F.G) {
        const int pair = it0 >> 2, b = pair >> 1, kvh = pair & 1, t0 = (it0 & 3) * 512;
        __syncthreads();
        { const int g = tid >> 7, rel = tid & 127; sB[tid] = F.rel_bias[t5_bucket(rel) * AQH + kvh * 4 + g] * LOG2E; }
        __syncthreads();
        for (int g = 0; g < 4; ++g) {
            const int hq = kvh * 4 + g, t = t0 + tid; const size_t m = (size_t)b * SEQ + t;
            float q[64], o[64];
            const bf16* qp = F.QKVG + m * NQ + C_AQ + 64 * hq;
#pragma unroll
            for (int d = 0; d < 64; ++d) { q[d] = bf2f(qp[d]); o[d] = 0.f; }
            float mx = F.attn_sinks[hq] * LOG2E, l = 1.0f;
            for (int rel = 0; rel < WINDOW; ++rel) {
                const int s = t - rel;
                if (s >= 0) {
                    const bf16* kp = F.QKVG + ((size_t)b * SEQ + s) * NQ + C_AK + 64 * kvh; const bf16* vp = kp + (C_AV - C_AK);
                    float dot = 0.f;
#pragma unroll
                    for (int d8 = 0; d8 < 8; ++d8) { const v4u kk = *(const v4u*)(kp + 8 * d8);
                        dot += q[8 * d8 + 0] * bflo(kk.x) + q[8 * d8 + 1] * bfhi(kk.x) + q[8 * d8 + 2] * bflo(kk.y) + q[8 * d8 + 3] * bfhi(kk.y)
                             + q[8 * d8 + 4] * bflo(kk.z) + q[8 * d8 + 5] * bfhi(kk.z) + q[8 * d8 + 6] * bflo(kk.w) + q[8 * d8 + 7] * bfhi(kk.w); }
                    const float logit = dot + sB[g * 128 + rel];
                    if (logit > mx) { const float f = exp2f(mx - logit); l *= f;
#pragma unroll
                        for (int d = 0; d < 64; ++d) o[d] *= f;
                        mx = logit; }
                    const float p = exp2f(logit - mx); l += p;
#pragma unroll
                    for (int d8 = 0; d8 < 8; ++d8) { const v4u vv = *(const v4u*)(vp + 8 * d8);
                        o[8 * d8 + 0] += p * bflo(vv.x); o[8 * d8 + 1] += p * bfhi(vv.x); o[8 * d8 + 2] += p * bflo(vv.y); o[8 * d8 + 3] += p * bfhi(vv.y);
                        o[8 * d8 + 4] += p * bflo(vv.z); o[8 * d8 + 5] += p * bfhi(vv.z); o[8 * d8 + 6] += p * bflo(vv.w); o[8 * d8 + 7] += p * bfhi(vv.w); }
                }
            }
            const float rl = 1.0f / l;
            const bf16* gp = F.QKVG + m * NQ + C_G + 64 * hq; bf16* yp = F.R2 + m * D + 64 * hq;
#pragma unroll
            for (int d = 0; d < 64; ++d) { const float gg = bf2f(gp[d]); yp[d] = (bf16)f2bf(o[d] * rl * gg * sigmoidf_(gg)); }
        }
    }
    __syncthreads();
}
__device__ __forceinline__ void p5_naive(Frame& F) {
    LAS float* sXc = (LAS float*)(F.lds + RING_OFF);
    const int tid = F.tid, cl = tid >> 2, part = tid & 3;
    for (int item = F.vcu; item < BATCH * 8; item += F.G) {
        const int b = item >> 3, n = item & 7, c = n * 128 + cl;
        const float w0 = F.lru_conv_w[c], w1 = F.lru_conv_w[1024 + c], w2 = F.lru_conv_w[2048 + c], w3 = F.lru_conv_w[3072 + c], cb = F.lru_conv_b[c];
        const float ba = F.lru_b_a[c], bx = F.lru_b_x[c];
        const float lam = F.lru_lambda[c], sp = fmaxf(-lam, 0.f) + log1pf(expf(-fabsf(lam)));
        const bf16* wa = F.WAT + (size_t)n * 16384 + (size_t)cl * 128 + 32 * part; const bf16* wx = F.WXT + (size_t)n * 16384 + (size_t)cl * 128 + 32 * part;
        float wav[32], wxv[32];
#pragma unroll
        for (int i = 0; i < 32; ++i) { wav[i] = bf2f(wa[i]); wxv[i] = bf2f(wx[i]); }
        float xm1 = 0.f, xm2 = 0.f, xm3 = 0.f, hst = 0.f;
        __syncthreads();
        for (int t = 0; t < SEQ; ++t) {
            const size_t m = (size_t)b * SEQ + t;
            const float x0 = bf2f(F.XG[m * NXG + c]);
            const float xc = cb + w0 * xm3 + w1 * xm2 + w2 * xm1 + w3 * x0;
            xm3 = xm2; xm2 = xm1; xm1 = x0;
            LAS float* sx = sXc + (t & 1) * 128;
            if (part == 0) sx[cl] = xc;
            __syncthreads();
            float ra = 0.f, ia = 0.f;
#pragma unroll
            for (int i = 0; i < 32; ++i) { const float xv = sx[32 * part + i]; ra += xv * wav[i]; ia += xv * wxv[i]; }
            ra += __shfl_xor(ra, 1); ra += __shfl_xor(ra, 2); ia += __shfl_xor(ia, 1); ia += __shfl_xor(ia, 2);
            const float r = sigmoidf_(ra + ba), ig = sigmoidf_(ia + bx);
            const float log_a = -8.0f * r * sp, a = expf(log_a), mult = sqrtf(-expm1f(2.0f * log_a));
            hst = a * hst + mult * (ig * xc);
            if (part == 0) { const float g = bf2f(F.XG[m * NXG + 1024 + c]); F.R2[m * D + c] = (bf16)f2bf(hst * g * sigmoidf_(g)); }
        }
        __syncthreads();
    }
}

template <int EPI> __device__ __forceinline__ void naive_gemm(Frame& F, const bf16* A, const bf16* Bt, int N) {
    const int gw = F.vcu * NWAVES + F.wave, NGW = F.G * NWAVES, nch = N / 64;
    for (long it = gw; it < (long)M * nch; it += NGW) {
        const int m = (int)(it / nch), ch = (int)(it % nch), n = ch * 64 + F.lane, b = m / SEQ;
        const bf16* ap = A + (size_t)m * D; const bf16* bp = Bt + (size_t)n * D;
        float acc = 0.f;
        for (int k = 0; k < D; k += 8) { const v4u a = *(const v4u*)(ap + k), w = *(const v4u*)(bp + k);
            acc += bflo(a.x) * bflo(w.x) + bfhi(a.x) * bfhi(w.x) + bflo(a.y) * bflo(w.y) + bfhi(a.y) * bfhi(w.y) + bflo(a.z) * bflo(w.z) + bfhi(a.z) * bfhi(w.z) + bflo(a.w) * bflo(w.w) + bfhi(a.w) * bfhi(w.w); }
        if (EPI == 0) { const int pn = n >> 8; const float s = (pn == 0 || pn == 1 || pn == 3 || pn == 4) ? QSCALE : 1.f; F.QKVG[(size_t)m * NQ + n] = (bf16)f2bf(acc * s); }
        if (EPI == 1) { const float x1 = F.x[(size_t)m * D + n] + F.mod[(size_t)b * 3072 + 2048 + n] * acc; F.x1[(size_t)m * D + n] = x1;
            F.A1[(size_t)m * D + n] = (bf16)f2bf(x1 * F.gs[32 * 1024 + b * 1024 + n]); const float ss = wave_sum(x1 * x1); if (F.lane == 0) F.part[(size_t)m * 16 + ch] = ss; }
        if (EPI == 2) { float ps = F.part[(size_t)m * 16 + (F.lane & 15)]; ps += __shfl_xor(ps, 1); ps += __shfl_xor(ps, 2); ps += __shfl_xor(ps, 4); ps += __shfl_xor(ps, 8);
            const float rstd = 1.0f / sqrtf(ps * (1.0f / D) + EPS); F.XG[(size_t)m * NXG + n] = (bf16)f2bf(acc * rstd + F.sw1[(size_t)b * 2048 + n]); }
        if (EPI == 3) { const float x2 = F.x1[(size_t)m * D + n] + F.mod[(size_t)(32 + b) * 3072 + 2048 + n] * acc; F.out[(size_t)m * D + n] = x2;
            const float ss = wave_sum(x2 * x2); if (F.lane == 0) F.part2[(size_t)m * 16 + ch] = ss; }
    }
}

struct Args { const float* in[20]; float* out; unsigned char* ws; int ph_lo, ph_hi, li, pad; };
__global__ void __launch_bounds__(NWAVES * 64, 2) mk_fwd(Args args) {
    extern __shared__ __attribute__((aligned(16))) unsigned char lds[];
    Frame F;
    F.lds = (LAS unsigned char*)lds;
    F.MISC = (volatile LAS unsigned*)(F.lds + MISC_OFF);
    F.tid = threadIdx.x; F.lane = F.tid & 63; F.wave = __builtin_amdgcn_readfirstlane(F.tid >> 6);
    F.G = gridDim.x; { const int bx = blockIdx.x; F.vcu = (F.G % 8 == 0) ? (bx % 8) * (F.G / 8) + bx / 8 : bx; }
    unsigned char* ws = args.ws;
    F.ctl = (gu32*)(ws + WS_CTL);
    F.x = args.in[0]; F.c = args.in[1]; F.rel_bias = args.in[2]; F.norm_g = args.in[3]; F.ada_w = args.in[4]; F.ada_b = args.in[5]; F.attn_w_in = args.in[6]; F.attn_sinks = args.in[7];
    F.attn_b_f = args.in[8]; F.attn_w_out = args.in[9]; F.lru_w_in = args.in[10]; F.lru_conv_w = args.in[11]; F.lru_conv_b = args.in[12]; F.lru_w_a = args.in[13]; F.lru_b_a = args.in[14];
    F.lru_w_x = args.in[15]; F.lru_b_x = args.in[16]; F.lru_lambda = args.in[17]; F.lru_w_out = args.in[18]; F.final_g = args.in[19]; F.out = args.out;
    F.mod = (float*)(ws + WS_MOD); F.gs = (float*)(ws + WS_GS); F.sw1 = (float*)(ws + WS_SW1); F.part = (float*)(ws + WS_PART); F.part2 = (float*)(ws + WS_PART2); F.lf = (float*)(ws + WS_LF);
    F.x1 = (float*)(ws + WS_X1);
    F.W0T = (bf16*)(ws + WS_W0T); F.WO0T = (bf16*)(ws + WS_WO0T); F.W1T = (bf16*)(ws + WS_W1T); F.WO1T = (bf16*)(ws + WS_WO1T); F.WAT = (bf16*)(ws + WS_WAT); F.WXT = (bf16*)(ws + WS_WXT);
    F.R2 = (bf16*)(ws + WS_R2); F.QKVG = (bf16*)(ws + WS_R1); F.A1 = (bf16*)(ws + WS_A1); F.XG = (bf16*)(ws + WS_XG);
    for (int u = F.tid; u < (LDS_BYTES - LDSCTL_OFF) / 4; u += NWAVES * 64) ((LAS unsigned*)(F.lds + LDSCTL_OFF))[u] = 0u;
    __syncthreads();
    XcdBarrier bar; bar.bar = (unsigned*)(F.ctl + CW_BAR); bar.x = 0; bar.st = nullptr;
    if (N_LAUNCHES == 1) bar = xcd_barrier_post((unsigned*)(F.ctl + CW_BAR), F.MISC + 8);
    const int lo = args.ph_lo, hi = args.ph_hi;
#define IN(k) (lo <= (k) && (k) < hi)
#define SEAM(k) do { if (IN(k) && IN((k) + 1)) xcd_barrier(bar); } while (0)

    if (IN(0)) { p0a(F); SEAM(0); }
    if (IN(1)) { p0b(F); SEAM(1); }
    if (IN(2)) {
        pg8::Gemm g{F.R2, F.W0T, M, NQ, D}; pg8::StaticOrder S; S.init(M, NQ, F.G, (int)blockIdx.x);
        pg8::EpiQKVG E{F.QKVG, NQ, (1u << 0) | (1u << 1) | (1u << 3) | (1u << 4), QSCALE};
#if GEMM_NAIVE & 1
        naive_gemm<0>(F, F.R2, F.W0T, NQ); (void)g; (void)S; (void)E;
#else
        pg8::gemm_phase<pg8::EpiQKVG, pg8::StaticOrder, true, true>(F.lds + RING_OFF, g, S, E);
#endif
        SEAM(2);
    }
    if (IN(3)) {
#if P2_NAIVE
        p2_naive(F);
#else
        p2_attn(F);
#endif
        SEAM(3);
    }
    if (IN(4)) {
        pg8::Gemm g{F.R2, F.WO0T, M, D, D}; pg8::StaticOrder S; S.init(M, D, F.G, (int)blockIdx.x);
        pg8::EpiRes0 E0{F.x, F.x1, F.A1, F.mod + 2048, 3072, F.gs + 32 * 1024, 1024, F.part};
#if GEMM_NAIVE & 2
        naive_gemm<1>(F, F.R2, F.WO0T, D); (void)g; (void)S; (void)E0;
#else
        pg8::gemm_phase<pg8::EpiRes0, pg8::StaticOrder, true, true>(F.lds + RING_OFF, g, S, E0);
#endif
        SEAM(4);
    }
    if (IN(5)) {
        pg8::Gemm g{F.A1, F.W1T, M, NXG, D}; pg8::StaticOrder S; S.init(M, NXG, F.G, (int)blockIdx.x);
        pg8::EpiXG E{F.XG, NXG, F.part, F.sw1, 2048, EPS};
#if GEMM_NAIVE & 4
        naive_gemm<2>(F, F.A1, F.W1T, NXG); (void)g; (void)S; (void)E;
#else
        pg8::gemm_phase<pg8::EpiXG, pg8::StaticOrder, true, true>(F.lds + RING_OFF, g, S, E);
#endif
        SEAM(5);
    }
    if (IN(6)) {
#if P5_NAIVE
        p5_naive(F);
#else
        p5_lru(F);
#endif
        SEAM(6);
    }
    if (IN(7)) {
        pg8::Gemm g{F.R2, F.WO1T, M, D, D}; pg8::StaticOrder S; S.init(M, D, F.G, (int)blockIdx.x);
        pg8::EpiRes1 E{F.x1, F.out, nullptr, F.mod + (size_t)32 * 3072 + 2048, 3072, nullptr, 0, F.part2};
#if GEMM_NAIVE & 8
        naive_gemm<3>(F, F.R2, F.WO1T, D); (void)g; (void)S; (void)E;
#else
        pg8::gemm_phase<pg8::EpiRes1, pg8::StaticOrder, true, true>(F.lds + RING_OFF, g, S, E);
#endif
        SEAM(7);
    }
    if (IN(8)) { p7(F); }
#undef IN
#undef SEAM
}

extern "C" void kernel_launch(void* const* d_in, const int* in_sizes, int n_in, void* d_out, int out_size, void* d_ws, size_t ws_size, hipStream_t stream) {
    static int grid = 0;
    if (grid == 0) {
        if (n_in != 20 || in_sizes[0] != M * D || out_size != M * D || ws_size < WS_END) { fprintf(stderr, "kernel_launch: unexpected shapes (n_in %d, in0 %d, out %d, ws %zu)\n", n_in, n_in > 0 ? in_sizes[0] : -1, out_size, ws_size); grid = -1; return; }
        int dev = 0, cus = 0;
        if (hipGetDevice(&dev) != hipSuccess || hipDeviceGetAttribute(&cus, hipDeviceAttributeMultiprocessorCount, dev) != hipSuccess) { grid = -1; return; }
        if (hipFuncSetAttribute((const void*)mk_fwd, hipFuncAttributeMaxDynamicSharedMemorySize, LDS_BYTES) != hipSuccess) { fprintf(stderr, "kernel_launch: hipFuncSetAttribute failed\n"); grid = -1; return; }
        (void)hipGetLastError();
        grid = cus;
    }
    if (grid < 0) return;
    if (hipMemsetAsync((char*)d_ws + WS_CTL, 0, CTL_ZERO_BYTES, stream) != hipSuccess) return;
    Args a{};
    for (int i = 0; i < 20; ++i) a.in[i] = (const float*)d_in[i];
    a.out = (float*)d_out; a.ws = (unsigned char*)d_ws;
    for (int li = 0; li < N_LAUNCHES; ++li) {
        a.ph_lo = (N_LAUNCHES == 1) ? 0 : li; a.ph_hi = (N_LAUNCHES == 1) ? N_PHASES : li + 1; a.li = li;
        hipLaunchKernelGGL(mk_fwd, dim3(grid), dim3(NWAVES * 64), LDS_BYTES, stream, a);
    }
}
```

```cpp
#include <hip/hip_runtime.h>
#include <cstdio>
#include <cstdint>
#include <cmath>
namespace pg8 {
#define PG8_LAS __attribute__((address_space(3)))
typedef unsigned short bf16_t;
typedef short bf16x8 __attribute__((ext_vector_type(8)));
typedef float f32x4 __attribute__((ext_vector_type(4)));
typedef unsigned u32x4 __attribute__((ext_vector_type(4)));
constexpr int BM = 256, BK = 64, HALF = 128, HTB = HALF * BK * 2  , STAGE_BYTES = 8 * HTB, NXCD = 8, WGM = 8;

__host__ __device__ __forceinline__ int lds_byte(int r, int c) { const int st = (r >> 4) * 2 + (c >> 5), rr = r & 15, cc = c & 31, ob = rr * 64 + cc * 2; return st * 1024 + (ob ^ (((ob >> 9) & 1) << 5)); }
__host__ __device__ __forceinline__ void stage_rc(int b, int& R, int& C) { const int st = b / 1024, sb = b % 1024, swz = sb ^ (((sb >> 9) & 1) << 5); R = (st >> 1) * 16 + swz / 64; C = (st & 1) * 32 + (swz % 64) / 2; }
__host__ __device__ __forceinline__ int perm32(int rho) { const int n = rho >> 4, i = rho & 15; return 8 * (i >> 2) + 4 * n + (i & 3); }

struct Unit { int pm, pn; };
struct Gemm { const bf16_t* A; const bf16_t* Bt; int M, N, K; };

struct StaticOrder {
    int nM, nN, nwg, G, c;
    __host__ __device__ void init(int M, int N, int G_, int c_) { nM = M / BM; nN = N / BM; nwg = nM * nN; G = G_; c = c_; }
    __host__ __device__ bool next(int i, Unit& u) const {
        const long L = (long)i * G + c; if (L >= nwg) return false;
        int wgid = (int)L; { const int q = nwg / NXCD, r = nwg % NXCD, xcd = wgid % NXCD, off = wgid / NXCD; wgid = (xcd < r ? xcd * (q + 1) : r * (q + 1) + (xcd - r) * q) + off; }
        const int nig = WGM * nN, gid = wgid / nig, fm = gid * WGM, gsz = (nM - fm) < WGM ? (nM - fm) : WGM;
        u.pm = fm + ((wgid % nig) % gsz); u.pn = (wgid % nig) / gsz; return true;
    }
    __device__ __forceinline__ void a_ready(const Unit&) const {}
    __device__ __forceinline__ void done(const Unit&) const {}
};

__device__ __forceinline__ unsigned cvt_pk_bf16(float lo, float hi) { unsigned r; asm volatile("v_cvt_pk_bf16_f32 %0, %1, %2" : "=v"(r) : "v"(lo), "v"(hi)); return r; }
struct EpiQKVG {
    static constexpr bool PERM = true, AFTER_DRAIN = false;
    bf16_t* O; int ldc; unsigned scale_mask; float sc;
    __device__ __forceinline__ void operator()(const f32x4 (&acc)[2][2][4][2], const Unit& u, int wr, int wc, int fr, int fq) const {
        const float s = ((scale_mask >> u.pn) & 1u) ? sc : 1.f;
        const int row0 = u.pm * BM + wr * 64 + fr, col0 = u.pn * BM + wc * 32 + 8 * fq;
#pragma unroll
        for (int ai = 0; ai < 2; ++ai)
#pragma unroll
            for (int m = 0; m < 4; ++m) { bf16_t* rowp = O + (size_t)(row0 + ai * HALF + m * 16) * ldc + col0;
#pragma unroll
                for (int bj = 0; bj < 2; ++bj) { const f32x4 v0 = acc[ai][bj][m][0] * s, v1 = acc[ai][bj][m][1] * s;
                    u32x4 w; w.x = cvt_pk_bf16(v0[0], v0[1]); w.y = cvt_pk_bf16(v0[2], v0[3]); w.z = cvt_pk_bf16(v1[0], v1[1]); w.w = cvt_pk_bf16(v1[2], v1[3]);
                    *(u32x4*)(rowp + bj * HALF) = w; } }
    }
};
template <bool WITH_A> struct EpiRes {
    static constexpr bool PERM = true, AFTER_DRAIN = false;
    const float* XI; float* XO; bf16_t* AO; const float* gm; int gmp; const float* gs; int gsp; float* part;
    __device__ __forceinline__ void operator()(const f32x4 (&acc)[2][2][4][2], const Unit& u, int wr, int wc, int fr, int fq) const {
        const int b = u.pm >> 3;
        const int col0 = u.pn * BM + wc * 32 + 8 * fq;
        f32x4 gmv[2][2], gsv[2][2];
#pragma unroll
        for (int bj = 0; bj < 2; ++bj)
#pragma unroll
            for (int n = 0; n < 2; ++n) { gmv[bj][n] = *(const f32x4*)(gm + (size_t)b * gmp + col0 + bj * HALF + 4 * n);
                if (WITH_A) gsv[bj][n] = *(const f32x4*)(gs + (size_t)b * gsp + col0 + bj * HALF + 4 * n); }
#pragma unroll
        for (int ai = 0; ai < 2; ++ai)
#pragma unroll
            for (int m = 0; m < 4; ++m) { const int row = u.pm * BM + ai * HALF + wr * 64 + m * 16 + fr; const size_t off = (size_t)row * 1024 + col0;
                float ss = 0.f;
#pragma unroll
                for (int bj = 0; bj < 2; ++bj) {
                    const f32x4 xa = *(const f32x4*)(XI + off + bj * HALF), xb = *(const f32x4*)(XI + off + bj * HALF + 4);
                    const f32x4 o0 = xa + gmv[bj][0] * acc[ai][bj][m][0], o1 = xb + gmv[bj][1] * acc[ai][bj][m][1];
                    *(f32x4*)(XO + off + bj * HALF) = o0; *(f32x4*)(XO + off + bj * HALF + 4) = o1;
                    ss += (o0[0] * o0[0] + o0[1] * o0[1]) + (o0[2] * o0[2] + o0[3] * o0[3]) + (o1[0] * o1[0] + o1[1] * o1[1]) + (o1[2] * o1[2] + o1[3] * o1[3]);
                    if (WITH_A) { const f32x4 a0 = o0 * gsv[bj][0], a1 = o1 * gsv[bj][1];
                        u32x4 w; w.x = cvt_pk_bf16(a0[0], a0[1]); w.y = cvt_pk_bf16(a0[2], a0[3]); w.z = cvt_pk_bf16(a1[0], a1[1]); w.w = cvt_pk_bf16(a1[2], a1[3]);
                        *(u32x4*)(AO + off + bj * HALF) = w; } }
                ss += __shfl_xor(ss, 16); ss += __shfl_xor(ss, 32);
                if (fq == 0) part[(size_t)row * 16 + u.pn * 4 + wc] = ss;
                if (m & 1) asm volatile("" ::: "memory"); }
    }
};
struct EpiXG {
    static constexpr bool PERM = true, AFTER_DRAIN = false;
    bf16_t* O; int ldc; const float* part; const float* sw; int swpitch; float eps;
    __device__ __forceinline__ void operator()(const f32x4 (&acc)[2][2][4][2], const Unit& u, int wr, int wc, int fr, int fq) const {
        const int b = u.pm >> 3;
        const int col0 = u.pn * BM + wc * 32 + 8 * fq;
        f32x4 swv[2][2];
#pragma unroll
        for (int bj = 0; bj < 2; ++bj)
#pragma unroll
            for (int n = 0; n < 2; ++n) swv[bj][n] = *(const f32x4*)(sw + (size_t)b * swpitch + col0 + bj * HALF + 4 * n);
#pragma unroll
        for (int ai = 0; ai < 2; ++ai)
#pragma unroll
            for (int m = 0; m < 4; ++m) { const int row = u.pm * BM + ai * HALF + wr * 64 + m * 16 + fr;
                const f32x4* pp = (const f32x4*)(part + (size_t)row * 16); const f32x4 p0 = pp[0], p1 = pp[1], p2 = pp[2], p3 = pp[3];
                const float ssum = ((p0[0] + p0[1]) + (p0[2] + p0[3])) + ((p1[0] + p1[1]) + (p1[2] + p1[3])) + ((p2[0] + p2[1]) + (p2[2] + p2[3])) + ((p3[0] + p3[1]) + (p3[2] + p3[3]));
                const float rstd = 1.0f / sqrtf(ssum * (1.0f / 1024.0f) + eps);
                bf16_t* rowp = O + (size_t)row * ldc + col0;
#pragma unroll
                for (int bj = 0; bj < 2; ++bj) { const f32x4 v0 = acc[ai][bj][m][0] * rstd + swv[bj][0], v1 = acc[ai][bj][m][1] * rstd + swv[bj][1];
                    u32x4 w; w.x = cvt_pk_bf16(v0[0], v0[1]); w.y = cvt_pk_bf16(v0[2], v0[3]); w.z = cvt_pk_bf16(v1[0], v1[1]); w.w = cvt_pk_bf16(v1[2], v1[3]);
                    *(u32x4*)(rowp + bj * HALF) = w; } }
    }
};
typedef EpiRes<true> EpiRes0; typedef EpiRes<false> EpiRes1;
template <class Epi, class Sched, bool ALIGN_EPI = false, bool SP2 = false>
__device__ __forceinline__ void gemm_phase(PG8_LAS unsigned char* lds, const Gemm g, const Sched& S, const Epi& E) {
    const int tid = threadIdx.x, wid = __builtin_amdgcn_readfirstlane(tid >> 6), lane = tid & 63, wr = wid >> 2, wc = wid & 3, fr = lane & 15, fq = lane >> 4;
    const int K = g.K, nt = K / BK;
    unsigned voffA[2], voffB[2];
#pragma unroll
    for (int i = 0; i < 2; ++i) { int R, C; stage_rc(tid * 16 + i * 8192, R, C); const int Rb = Epi::PERM ? ((R & ~31) + perm32(R & 31)) : R;
        voffA[i] = (unsigned)(R * K + C) * 2u; voffB[i] = (unsigned)(Rb * K + C) * 2u; }
    const size_t kstep = (size_t)(BK * 2);
    const size_t hstep = (size_t)HALF * K * 2;
    const size_t tstep = 2 * hstep;
    const unsigned ldsw = (unsigned)wid * 1024u;
    const int aoff = lds_byte(wr * 64 + fr, fq * 8), boff = lds_byte(wc * 32 + fr, fq * 8);
#define PG8_SA(b, h) (((b) * 2 + (h)) * HTB)
#define PG8_SB(b, h) ((4 + (b) * 2 + (h)) * HTB)
#define PG8_STAGE(bufoff, gbase, voff) do { _Pragma("unroll") for (int _i = 0; _i < 2; ++_i) \
        __builtin_amdgcn_global_load_lds((const unsigned*)((const char*)(gbase) + (voff)[_i]), (PG8_LAS unsigned*)(lds + (bufoff) + ldsw + _i * 8192), 16, 0, 0); } while (0)
#define PG8_LDA(dst, b, h) do { _Pragma("unroll") for (int m = 0; m < 4; ++m) _Pragma("unroll") for (int k = 0; k < 2; ++k) dst[m][k] = *(const PG8_LAS bf16x8*)(lds + PG8_SA(b, h) + aoff + m * 2048 + k * 1024); } while (0)
#define PG8_LDB(dst, b, h) do { _Pragma("unroll") for (int n = 0; n < 2; ++n) _Pragma("unroll") for (int k = 0; k < 2; ++k) dst[n][k] = *(const PG8_LAS bf16x8*)(lds + PG8_SB(b, h) + boff + n * 2048 + k * 1024); } while (0)
#define PG8_MMA(ai, bj, At, Bt) do { __builtin_amdgcn_s_setprio(1); _Pragma("unroll") for (int m = 0; m < 4; ++m) _Pragma("unroll") for (int n = 0; n < 2; ++n) _Pragma("unroll") for (int k = 0; k < 2; ++k) \
        acc[ai][bj][m][n] = __builtin_amdgcn_mfma_f32_16x16x32_bf16(Bt[n][k], At[m][k], acc[ai][bj][m][n], 0, 0, 0); __builtin_amdgcn_s_setprio(0); } while (0)
#define PG8_WAIT_V(n) asm volatile("s_waitcnt vmcnt(" #n ")" ::: "memory")
#define PG8_WAIT_L(n) asm volatile("s_waitcnt lgkmcnt(" #n ")" ::: "memory")
#define PG8_BAR __builtin_amdgcn_s_barrier()
#define PG8_SCHED __builtin_amdgcn_sched_barrier(0)
    Unit cur, nxt; int ui = 0;
    if (!S.next(0, cur)) return;
    f32x4 acc[2][2][4][2];
#pragma unroll
    for (int a = 0; a < 2; ++a)
#pragma unroll
        for (int b = 0; b < 2; ++b)
#pragma unroll
            for (int m = 0; m < 4; ++m)
#pragma unroll
                for (int n = 0; n < 2; ++n) acc[a][b][m][n] = (f32x4){0.f, 0.f, 0.f, 0.f};
    bf16x8 At[4][2], B0[2][2], B1[2][2];
    const char* cA = (const char*)g.A + (size_t)cur.pm * tstep; const char* cB = (const char*)g.Bt + (size_t)cur.pn * tstep;
    S.a_ready(cur);
    if constexpr (SP2) {
        PG8_STAGE(PG8_SB(0, 0), cB, voffB); PG8_STAGE(PG8_SB(0, 1), cB + hstep, voffB); PG8_STAGE(PG8_SA(0, 0), cA, voffA); PG8_STAGE(PG8_SA(0, 1), cA + hstep, voffA);
        if (wr == 1) PG8_BAR;
        PG8_WAIT_V(2); PG8_BAR;
        PG8_STAGE(PG8_SB(1, 0), cB + kstep, voffB); PG8_STAGE(PG8_SA(1, 0), cA + kstep, voffA); PG8_STAGE(PG8_SB(1, 1), cB + hstep + kstep, voffB);
        PG8_WAIT_V(6); PG8_BAR;
    } else {
        PG8_STAGE(PG8_SB(0, 0), cB, voffB); PG8_STAGE(PG8_SA(0, 0), cA, voffA); PG8_STAGE(PG8_SB(0, 1), cB + hstep, voffB); PG8_STAGE(PG8_SA(0, 1), cA + hstep, voffA);
        if (wr == 1) PG8_BAR;
        PG8_WAIT_V(4); PG8_BAR;
        PG8_STAGE(PG8_SB(1, 0), cB + kstep, voffB); PG8_STAGE(PG8_SA(1, 0), cA + kstep, voffA); PG8_STAGE(PG8_SB(1, 1), cB + hstep + kstep, voffB);
        PG8_WAIT_V(6); PG8_BAR;
    }
    for (;;) {
        const bool has_next = S.next(ui + 1, nxt);
        const char* nA = has_next ? (const char*)g.A + (size_t)nxt.pm * tstep : cA; const char* nB = has_next ? (const char*)g.Bt + (size_t)nxt.pn * tstep : cB;
        for (int t = 0; t < nt; t += 2) {
            const bool last = (t == nt - 2);
            const char* a1 = cA + (size_t)(t + 1) * kstep;
            const char* a2 = last ? nA : cA + (size_t)(t + 2) * kstep; const char* b2 = last ? nB : cB + (size_t)(t + 2) * kstep;
            const char* a3 = a2 + kstep; const char* b3 = b2 + kstep;
            if (last && has_next) S.a_ready(nxt);
            if constexpr (SP2) {
            PG8_LDB(B0, 0, 0); PG8_LDB(B1, 0, 1); PG8_SCHED; PG8_LDA(At, 0, 0); PG8_STAGE(PG8_SA(1, 1), a1 + hstep, voffA);
            PG8_WAIT_V(8); PG8_WAIT_L(0); PG8_BAR; PG8_MMA(0, 0, At, B0); PG8_MMA(0, 1, At, B1); PG8_BAR; PG8_SCHED;
            PG8_LDA(At, 0, 1); PG8_STAGE(PG8_SB(0, 0), b2, voffB); PG8_STAGE(PG8_SB(0, 1), b2 + hstep, voffB); PG8_STAGE(PG8_SA(0, 0), a2, voffA);
            PG8_WAIT_V(8); PG8_WAIT_L(0); PG8_BAR; PG8_MMA(1, 0, At, B0); PG8_MMA(1, 1, At, B1); PG8_BAR; PG8_SCHED;
            PG8_LDB(B0, 1, 0); PG8_LDB(B1, 1, 1); PG8_SCHED; PG8_LDA(At, 1, 0); PG8_STAGE(PG8_SA(0, 1), a2 + hstep, voffA);
            PG8_WAIT_V(8); PG8_WAIT_L(0); PG8_BAR; PG8_MMA(0, 0, At, B0); PG8_MMA(0, 1, At, B1); PG8_BAR; PG8_SCHED;
            PG8_LDA(At, 1, 1); PG8_STAGE(PG8_SB(1, 0), b3, voffB); PG8_STAGE(PG8_SB(1, 1), b3 + hstep, voffB); PG8_STAGE(PG8_SA(1, 0), a3, voffA);
            PG8_WAIT_V(8); PG8_WAIT_L(0); PG8_BAR; PG8_MMA(1, 0, At, B0); PG8_MMA(1, 1, At, B1); PG8_BAR; PG8_SCHED;
            } else {
            PG8_LDB(B0, 0, 0); PG8_SCHED; PG8_LDA(At, 0, 0); PG8_STAGE(PG8_SA(1, 1), a1 + hstep, voffA);
            PG8_WAIT_L(8); PG8_BAR; PG8_WAIT_L(0); PG8_MMA(0, 0, At, B0); PG8_BAR; PG8_SCHED;
            PG8_LDB(B1, 0, 1); PG8_STAGE(PG8_SB(0, 0), b2, voffB);
            PG8_BAR; PG8_WAIT_L(0); PG8_MMA(0, 1, At, B1); PG8_BAR;
            PG8_LDA(At, 0, 1); PG8_STAGE(PG8_SA(0, 0), a2, voffA);
            PG8_BAR; PG8_WAIT_L(0); PG8_MMA(1, 0, At, B0); PG8_BAR; PG8_SCHED;
            PG8_STAGE(PG8_SB(0, 1), b2 + hstep, voffB);
            PG8_WAIT_V(6); PG8_BAR; PG8_MMA(1, 1, At, B1); PG8_BAR;
            PG8_LDB(B0, 1, 0); PG8_SCHED; PG8_LDA(At, 1, 0); PG8_STAGE(PG8_SA(0, 1), a2 + hstep, voffA);
            PG8_WAIT_L(8); PG8_BAR; PG8_WAIT_L(0); PG8_MMA(0, 0, At, B0); PG8_BAR; PG8_SCHED;
            PG8_LDB(B1, 1, 1); PG8_STAGE(PG8_SB(1, 0), b3, voffB);
            PG8_BAR; PG8_WAIT_L(0); PG8_MMA(0, 1, At, B1); PG8_BAR;
            PG8_LDA(At, 1, 1); PG8_STAGE(PG8_SA(1, 0), a3, voffA);
            PG8_BAR; PG8_WAIT_L(0); PG8_MMA(1, 0, At, B0); PG8_BAR; PG8_SCHED;
            PG8_STAGE(PG8_SB(1, 1), b3 + hstep, voffB);
            PG8_WAIT_V(6); PG8_BAR; PG8_MMA(1, 1, At, B1); PG8_BAR;
            }
        }
        if constexpr (ALIGN_EPI) { if (wr == 0) PG8_BAR; }
        if constexpr (!Epi::AFTER_DRAIN) { E(acc, cur, wr, wc, fr, fq); S.done(cur); }
        if (!has_next) break;
#pragma unroll
        for (int a = 0; a < 2; ++a)
#pragma unroll
            for (int b = 0; b < 2; ++b)
#pragma unroll
                for (int m = 0; m < 4; ++m)
#pragma unroll
                    for (int n = 0; n < 2; ++n) acc[a][b][m][n] = (f32x4){0.f, 0.f, 0.f, 0.f};
        cur = nxt; cA = nA; cB = nB; ++ui;
        if constexpr (ALIGN_EPI) { if (wr == 1) PG8_BAR; }
    }
    PG8_WAIT_V(0);
    if constexpr (!ALIGN_EPI) { if (wr == 0) PG8_BAR; }
    PG8_BAR;
    if constexpr (Epi::AFTER_DRAIN) { E.fused(acc, cur, wr, wc, fr, fq, lds, wid, lane); S.done(cur); }
#undef PG8_SA
#undef PG8_SB
#undef PG8_STAGE
#undef PG8_LDA
#undef PG8_LDB
#undef PG8_MMA
#undef PG8_WAIT_V
#undef PG8_WAIT_L
#undef PG8_BAR
#undef PG8_SCHED
}
}

constexpr int NWAVES = 8;
#ifndef MK_N_LAUNCHES
#define MK_N_LAUNCHES 1
#endif
constexpr int N_PHASES = 9;
constexpr int N_LAUNCHES = MK_N_LAUNCHES;
#ifndef GEMM_NAIVE
#define GEMM_NAIVE 0
#endif
#ifndef P2_NAIVE
#define P2_NAIVE 0
#endif
#ifndef P5_NAIVE
#define P5_NAIVE 0
#endif

constexpr int BATCH = 32, SEQ = 2048, D = 1024, M = BATCH * SEQ;
constexpr int HD = 64, AQH = 8, AKVH = 2, BH = 8, WINDOW = 128;
constexpr int ATTN_IN = 3336, NQ = 3328;
constexpr int C_AQ = 0, C_AK = 512, C_AV = 640, C_BQ = 768, C_BK = 1280, C_BV = 1792, C_G = 2304;
constexpr int LRU_W = 1024, NXG = 2048;
constexpr float EPS = 1e-6f, LOG2E = 1.4426950408889634f, QSCALE = 0.125f * 1.4426950408889634f;

constexpr size_t MiB = 1u << 20;
constexpr size_t WS_CTL = 0, CTL_ZERO_BYTES = 1 * MiB;
constexpr size_t WS_MOD = 1 * MiB;
constexpr size_t WS_GS = WS_MOD + 768 * 1024;
constexpr size_t WS_SW1 = 2 * MiB;
constexpr size_t WS_PART = 3 * MiB, WS_PART2 = 7 * MiB;
constexpr size_t WS_LF = 11 * MiB;
constexpr size_t WS_W0T = 16 * MiB, WS_WO0T = 23 * MiB, WS_W1T = 25 * MiB, WS_WO1T = 29 * MiB, WS_WAT = 31 * MiB, WS_WXT = WS_WAT + 256 * 1024;
constexpr size_t WS_R2 = 32 * MiB;
constexpr size_t WS_X1 = 160 * MiB;
constexpr size_t WS_R1 = 416 * MiB;
constexpr size_t WS_A1 = WS_R1, WS_XG = WS_R1 + 128 * MiB;
constexpr size_t WS_END = 832 * MiB;
static_assert(WS_W0T + (size_t)NQ * D * 2 <= WS_WO0T && WS_XG + (size_t)M * NXG * 2 <= WS_END && WS_R1 + (size_t)M * NQ * 2 <= WS_END, "ws map");
constexpr int CW_BAR = 4096;

constexpr int RING_OFF = 0, RING_BYTES = 131072;
constexpr int LDSCTL_OFF = RING_BYTES, MISC_OFF = LDSCTL_OFF + 320;
constexpr int LDS_BYTES = 147456;

#define GAS __attribute__((address_space(1)))
#define LAS __attribute__((address_space(3)))
typedef unsigned short bf16;
typedef unsigned v4u __attribute__((ext_vector_type(4)));
typedef unsigned v2u __attribute__((ext_vector_type(2)));
typedef float f32x4 __attribute__((ext_vector_type(4)));
typedef float f32x2 __attribute__((ext_vector_type(2)));
typedef short bf16x8 __attribute__((ext_vector_type(8)));
typedef GAS unsigned gu32;
#define RLX_AGENT __ATOMIC_RELAXED, __HIP_MEMORY_SCOPE_AGENT
#define LDS_WAIT() asm volatile("s_waitcnt lgkmcnt(0)" ::: "memory")
#define VM_WAIT() asm volatile("s_waitcnt vmcnt(0)" ::: "memory")
__device__ __forceinline__ unsigned f2bf(float f) { unsigned u = __builtin_bit_cast(unsigned, f); return (u + 0x7fffu + ((u >> 16) & 1u)) >> 16; }
__device__ __forceinline__ unsigned pk2(float lo, float hi) { return f2bf(lo) | (f2bf(hi) << 16); }
__device__ __forceinline__ float bf2f(unsigned short h) { return __builtin_bit_cast(float, (unsigned)h << 16); }
__device__ __forceinline__ float bflo(unsigned w) { return __builtin_bit_cast(float, w << 16); }
__device__ __forceinline__ float bfhi(unsigned w) { return __builtin_bit_cast(float, w & 0xffff0000u); }
__device__ __forceinline__ float sigmoidf_(float x) { return 1.0f / (1.0f + __expf(-x)); }
#define XB_TMO      128
#define XB_XCNT(j)  (256  + 64 * (j))
#define XB_XSUB(j)  (1280 + 64 * (j))
#define XB_XGEN(j)  (2304 + 64 * (j))
#define XB_TOP      3328
#define XB_TOPGEN   3392
#define XCD_BAR_WORDS 3456
#define XB_SPIN_CAP (1u << 18)

__device__ __forceinline__ unsigned xb_ld(unsigned* p)              { return __hip_atomic_load(p, __ATOMIC_RELAXED, __HIP_MEMORY_SCOPE_AGENT); }
__device__ __forceinline__ unsigned xb_add(unsigned* p, unsigned v) { return __hip_atomic_fetch_add(p, v, __ATOMIC_RELAXED, __HIP_MEMORY_SCOPE_AGENT); }
__device__ __forceinline__ unsigned xb_xcc_id() { return (unsigned)__builtin_amdgcn_s_getreg((3 << 11) | 20) & 0xFu; }
#define XB_SPIN(cond, bar) do { unsigned _sp = 0; while (cond) { __builtin_amdgcn_s_sleep(1); \
    if ((++_sp & 255u) == 0u) { if (xb_ld(&(bar)[XB_TMO])) break; if (_sp > XB_SPIN_CAP) { atomicAdd(&(bar)[XB_TMO], 1u); break; } } } } while (0)

struct XcdBarrier {
    unsigned* bar; unsigned x;
    volatile LAS unsigned* st;
};

__device__ __forceinline__ XcdBarrier xcd_barrier_post(unsigned* bar, volatile LAS unsigned* st) {
    XcdBarrier b; b.bar = bar; b.x = xb_xcc_id(); b.st = st;
    if (threadIdx.x == 0) (void)xb_add(&bar[XB_XCNT(b.x)], 1u);
    return b;
}
__device__ __forceinline__ void xcd_barrier_complete(unsigned* bar, unsigned x, unsigned& nloc, unsigned& nx) {
    const unsigned G = gridDim.x * gridDim.y * gridDim.z;
    unsigned sum, cnt, mine, sp = 0u;
    for (;;) {
        sum = 0u; cnt = 0u; mine = 0u;
#pragma unroll
        for (unsigned j = 0; j < 16; ++j) { const unsigned c = xb_ld(&bar[XB_XCNT(j)]); sum += c; cnt += (c > 0u) ? 1u : 0u; mine = (j == x) ? c : mine; }
        if (sum == G) break;
        __builtin_amdgcn_s_sleep(1);
        if ((++sp & 255u) == 0u) { if (xb_ld(&bar[XB_TMO])) break; if (sp > XB_SPIN_CAP) { atomicAdd(&bar[XB_TMO], 1u); break; } }
    }
    nloc = mine > 0u ? mine : 1u; nx = cnt > 0u ? cnt : 1u;
}

__device__ __forceinline__ void xcd_barrier(const XcdBarrier& b) {
    asm volatile("s_waitcnt vmcnt(0)" ::: "memory");
    __syncthreads();
    if (threadIdx.x == 0) {
        unsigned* bar = b.bar;
        __builtin_amdgcn_s_waitcnt(0);
        unsigned nloc = b.st[0], nx = b.st[1];
        if (nloc == 0u) { xcd_barrier_complete(bar, b.x, nloc, nx); b.st[0] = nloc; b.st[1] = nx; }
        const unsigned old = xb_add(&bar[XB_XSUB(b.x)], 1u);
        const unsigned gen = old / nloc;
        if (old + 1u == (gen + 1u) * nloc) {
            __builtin_amdgcn_fence(__ATOMIC_RELEASE, "agent");
            asm volatile("s_waitcnt vmcnt(0)" ::: "memory");
            const unsigned og = xb_add(&bar[XB_TOP], 1u);
            const unsigned tg = og / nx;
            if (og + 1u == (tg + 1u) * nx) xb_add(&bar[XB_TOPGEN], 1u);
            else XB_SPIN(xb_ld(&bar[XB_TOPGEN]) == tg, bar);
            __builtin_amdgcn_fence(__ATOMIC_ACQUIRE, "agent");
            xb_add(&bar[XB_XGEN(b.x)], 1u);
            asm volatile("s_waitcnt vmcnt(0)" ::: "memory");
        } else {
            XB_SPIN(xb_ld(&bar[XB_XGEN(b.x)]) == gen, bar);
            __builtin_amdgcn_fence(__ATOMIC_ACQUIRE, "agent");
            asm volatile("s_waitcnt vmcnt(0)" ::: "memory");
        }
    }
    __syncthreads();
}

struct Frame {
    LAS unsigned char* lds;
    volatile LAS unsigned* MISC;
    gu32* ctl;
    int tid, lane, wave;
    int vcu, G;
    const float *x, *c, *rel_bias, *norm_g, *ada_w, *ada_b, *attn_w_in, *attn_sinks, *attn_b_f, *attn_w_out, *lru_w_in, *lru_conv_w, *lru_conv_b, *lru_w_a, *lru_b_a, *lru_w_x, *lru_b_x, *lru_lambda, *lru_w_out, *final_g;
    float* out;
    float *mod, *gs, *sw1, *part, *part2, *lf, *x1;
    bf16 *W0T, *WO0T, *W1T, *WO1T, *WAT, *WXT, *R2, *QKVG, *A1, *XG;
};
__device__ __forceinline__ float wave_sum(float v) {
#pragma unroll
    for (int o = 1; o < 64; o <<= 1) v += __shfl_xor(v, o);
    return v;
}

__device__ __forceinline__ void p0_transpose_item(const float* W, int pitch, int K, int ncols, bf16* WT, LAS float* scr, int item, int lane) {
    const int nblk = ncols / 32, kb = item / nblk, nb = item % nblk, k0 = 64 * kb, n0 = 32 * nb;
#pragma unroll 8
    for (int i = 0; i < 32; ++i) { const int kk = 2 * i + (lane >> 5); scr[kk * 33 + (lane & 31)] = W[(size_t)(k0 + kk) * pitch + n0 + (lane & 31)]; }
    LDS_WAIT(); asm volatile("" ::: "memory");
    const int c = lane & 7;
#pragma unroll
    for (int j = 0; j < 4; ++j) { const int n = (lane >> 3) + 8 * j; const LAS float* s = scr + (8 * c) * 33 + n;
        v4u o; o.x = pk2(s[0 * 33], s[1 * 33]); o.y = pk2(s[2 * 33], s[3 * 33]); o.z = pk2(s[4 * 33], s[5 * 33]); o.w = pk2(s[6 * 33], s[7 * 33]);
        *(GAS v4u*)(WT + (size_t)(n0 + n) * K + k0 + 8 * c) = o; }
    LDS_WAIT(); asm volatile("" ::: "memory");
}
__device__ __forceinline__ void sg_stage(LAS float* sIn, const float* in, int in_pitch, bool act, int tid) {
    for (int idx = tid; idx < 32 * 1024; idx += NWAVES * 64) { const int k = idx >> 5, b = idx & 31; float v = in[(size_t)b * in_pitch + k]; if (act) v = v * sigmoidf_(v); sIn[idx] = v; }
    __syncthreads();
}
__device__ __forceinline__ void sg_block(LAS float* ring, const float* W, int wp, int col0, const float* bias, float* out, int out_pitch, int tid, int lane, int wave) {
    float acc[32];
#pragma unroll
    for (int b = 0; b < 32; ++b) acc[b] = 0.f;
    const float* wptr = W + (size_t)((tid >> 5) * 64) * wp + col0 + (tid & 31);
#pragma unroll 4
    for (int kk = 0; kk < 64; ++kk) { const float w = wptr[(size_t)kk * wp]; const LAS f32x4* s = (const LAS f32x4*)(ring + ((tid >> 5) * 64 + kk) * 32);
#pragma unroll
        for (int q = 0; q < 8; ++q) { const f32x4 v = s[q]; acc[4 * q] += w * v[0]; acc[4 * q + 1] += w * v[1]; acc[4 * q + 2] += w * v[2]; acc[4 * q + 3] += w * v[3]; } }
#pragma unroll
    for (int b = 0; b < 32; ++b) acc[b] += __shfl_xor(acc[b], 32);
    __syncthreads();
    if (lane < 32) {
#pragma unroll
        for (int b = 0; b < 32; ++b) ring[(wave * 32 + b) * 32 + lane] = acc[b];
    }
    __syncthreads();
#pragma unroll
    for (int h = 0; h < 2; ++h) { const int o = tid + h * 512, b = o >> 5, c2 = o & 31; float s = bias ? bias[col0 + c2] : 0.f;
#pragma unroll
        for (int g = 0; g < 8; ++g) s += ring[(g * 32 + b) * 32 + c2];
        out[(size_t)b * out_pitch + col0 + c2] = s; }
    __syncthreads();
}

__device__ __forceinline__ void p0a(Frame& F) {
    LAS float* ring = (LAS float*)(F.lds + RING_OFF);
    for (int it = F.vcu; it < 192; it += F.G) {
        sg_stage(ring, F.c, D, true, F.tid);
        const int l = it / 96, cb = it % 96;
        sg_block(ring, F.ada_w + (size_t)l * D * 3072, 3072, cb * 32, F.ada_b + l * 3072, F.mod + (size_t)l * 32 * 3072, 3072, F.tid, F.lane, F.wave);
    }
    LAS float* scr = (LAS float*)(F.lds + RING_OFF + F.wave * 16384);
    const int gw = F.vcu * NWAVES + F.wave, NGW = F.G * NWAVES;
    constexpr int I_W0A = (D / 64) * (2304 / 32), I_W0B = (D / 64) * (1024 / 32), I_SQ = (D / 64) * (D / 32), I_W1 = (D / 64) * (2048 / 32), I_G = (128 / 64) * (128 / 32);
    constexpr int NITEMS = I_W0A + I_W0B + I_SQ + I_W1 + I_SQ + 16 * I_G;
    for (int it = gw; it < NITEMS; it += NGW) {
        int r = it;
        if (r < I_W0A) { p0_transpose_item(F.attn_w_in, ATTN_IN, D, 2304, F.W0T, scr, r, F.lane); continue; } r -= I_W0A;
        if (r < I_W0B) { p0_transpose_item(F.attn_w_in + 2312, ATTN_IN, D, 1024, F.W0T + (size_t)2304 * D, scr, r, F.lane); continue; } r -= I_W0B;
        if (r < I_SQ) { p0_transpose_item(F.attn_w_out, D, D, D, F.WO0T, scr, r, F.lane); continue; } r -= I_SQ;
        if (r < I_W1) { p0_transpose_item(F.lru_w_in, 2048, D, 2048, F.W1T, scr, r, F.lane); continue; } r -= I_W1;
        if (r < I_SQ) { p0_transpose_item(F.lru_w_out, D, D, D, F.WO1T, scr, r, F.lane); continue; } r -= I_SQ;
        { const int mtx = r / I_G, item = r % I_G; const int n = mtx & 7;
          if (mtx < 8) p0_transpose_item(F.lru_w_a + (size_t)n * 16384, 128, 128, 128, F.WAT + (size_t)n * 16384, scr, item, F.lane);
          else         p0_transpose_item(F.lru_w_x + (size_t)n * 16384, 128, 128, 128, F.WXT + (size_t)n * 16384, scr, item, F.lane); }
    }
}

__device__ __forceinline__ void p0b(Frame& F) {
    LAS float* ring = (LAS float*)(F.lds + RING_OFF);
    for (int idx = F.vcu * 512 + F.tid; idx < 2 * 32 * 1024; idx += F.G * 512) { const int k = idx & 1023, lb = idx >> 10, l = lb >> 5;
        F.gs[idx] = F.norm_g[l * 1024 + k] * (1.0f + F.mod[(size_t)lb * 3072 + 1024 + k]); }
    for (int it = F.vcu; it < 64; it += F.G) {
        sg_stage(ring, F.mod + (size_t)32 * 3072, 3072, false, F.tid);
        sg_block(ring, F.lru_w_in, 2048, it * 32, nullptr, F.sw1, 2048, F.tid, F.lane, F.wave);
    }
    const int gw = F.vcu * NWAVES + F.wave, NGW = F.G * NWAVES;
    for (int ch = gw; ch < M / 32; ch += NGW) {
        const int b = ch >> 6;
        f32x4 gsv[4], shv[4], wf[16][2];
#pragma unroll
        for (int j = 0; j < 4; ++j) { const int k = 4 * F.lane + 256 * j;
            const f32x4 g = *(const f32x4*)(F.norm_g + k), sc = *(const f32x4*)(F.mod + (size_t)b * 3072 + 1024 + k);
            gsv[j] = g * (1.0f + sc); shv[j] = *(const f32x4*)(F.mod + (size_t)b * 3072 + k);
#pragma unroll
            for (int e = 0; e < 4; ++e) { const float* wp = F.attn_w_in + (size_t)(k + e) * ATTN_IN + 2304; wf[4 * j + e][0] = *(const f32x4*)wp; wf[4 * j + e][1] = *(const f32x4*)(wp + 4); } }
        const float bf_mine = F.attn_b_f[F.lane & 7];
        for (int r = 0; r < 32; ++r) {
            const int m = ch * 32 + r;
            const GAS f32x4* xr = (const GAS f32x4*)(F.x + (size_t)m * D) + F.lane;
            f32x4 v[4]; float ss = 0.f;
#pragma unroll
            for (int j = 0; j < 4; ++j) { v[j] = xr[64 * j]; ss += (v[j][0] * v[j][0] + v[j][1] * v[j][1]) + (v[j][2] * v[j][2] + v[j][3] * v[j][3]); }
            const float rstd = 1.0f / sqrtf(wave_sum(ss) * (1.0f / D) + EPS);
            float p[8];
#pragma unroll
            for (int q = 0; q < 8; ++q) p[q] = 0.f;
            GAS unsigned long long* o8 = (GAS unsigned long long*)(F.R2 + (size_t)m * D) + F.lane;
#pragma unroll
            for (int j = 0; j < 4; ++j) { const f32x4 h = v[j] * rstd * gsv[j] + shv[j];
                o8[64 * j] = (unsigned long long)pk2(h[0], h[1]) | ((unsigned long long)pk2(h[2], h[3]) << 32);
#pragma unroll
                for (int e = 0; e < 4; ++e) {
#pragma unroll
                    for (int q = 0; q < 4; ++q) { p[q] += h[e] * wf[4 * j + e][0][q]; p[4 + q] += h[e] * wf[4 * j + e][1][q]; } } }
#pragma unroll
            for (int q = 0; q < 8; ++q) p[q] = wave_sum(p[q]);
            float z = p[0];
#pragma unroll
            for (int q = 1; q < 8; ++q) z = ((F.lane & 7) == q) ? p[q] : z;
            z += bf_mine;
            const float lfv = fminf(z, 0.f) - log1pf(expf(-fabsf(z)));
            if (F.lane < 8) F.lf[(size_t)m * 8 + F.lane] = lfv;
        }
    }
}

__device__ __forceinline__ void p7(Frame& F) {
    const int gw = F.vcu * NWAVES + F.wave, NGW = F.G * NWAVES;
    f32x4 g[4];
#pragma unroll
    for (int j = 0; j < 4; ++j) g[j] = *(const f32x4*)(F.final_g + 4 * F.lane + 256 * j);
    for (int m = gw; m < M; m += NGW) {
        const float pv = F.part2[(size_t)m * 16 + (F.lane & 15)];
        float s = pv; s += __shfl_xor(s, 1); s += __shfl_xor(s, 2); s += __shfl_xor(s, 4); s += __shfl_xor(s, 8);
        const float rstd = 1.0f / sqrtf(s * (1.0f / D) + EPS);
        GAS f32x4* o = (GAS f32x4*)(F.out + (size_t)m * D) + F.lane;
#pragma unroll
        for (int j = 0; j < 4; ++j) { f32x4 v = o[64 * j]; o[64 * j] = v * rstd * g[j]; }
    }
}

__device__ __forceinline__ int t5_bucket(int rel) {
    if (rel < 16) return rel;
    const float v = logf((float)rel / 16.0f) / logf(8.0f) * 16.0f;
    int l = 16 + (int)v; return l < 31 ? l : 31;
}
__device__ __forceinline__ void block_cumsum_2048(const float* src, int stride, LAS float* sF, LAS float* sTmp, int tid, int lane, int wave) {
    float v0 = src[(size_t)(4 * tid + 0) * stride], v1 = src[(size_t)(4 * tid + 1) * stride], v2 = src[(size_t)(4 * tid + 2) * stride], v3 = src[(size_t)(4 * tid + 3) * stride];
    v1 += v0; v2 += v1; v3 += v2;
    float s = v3;
#pragma unroll
    for (int o = 1; o < 64; o <<= 1) { const float t = __shfl_up(s, o); if (lane >= o) s += t; }
    if (lane == 63) sTmp[wave] = s;
    __syncthreads();
    float base = s - v3;
    for (int w = 0; w < wave; ++w) base += sTmp[w];
    sF[4 * tid + 0] = base + v0; sF[4 * tid + 1] = base + v1; sF[4 * tid + 2] = base + v2; sF[4 * tid + 3] = base + v3;
    __syncthreads();
}
__device__ __forceinline__ void p2_naive(Frame& F) {
    LAS float* sF = (LAS float*)(F.lds + RING_OFF);
    LAS float* sTmp = sF + 2048;
    LAS float* sB = sF + 2048 + 64;
    const int tid = F.tid;
    for (int bh = F.vcu; bh < BATCH * BH; bh += F.G) {
        const int b = bh >> 3, h = bh & 7;
        block_cumsum_2048(F.lf + (size_t)b * SEQ * 8 + h, 8, sF, sTmp, tid, F.lane, F.wave);
        for (int it = 0; it < 4; ++it) {
            const int t = it * 512 + tid; const size_t m = (size_t)b * SEQ + t;
            float q[64], o[64];
            const bf16* qp = F.QKVG + m * NQ + C_BQ + 64 * h;
#pragma unroll
            for (int d = 0; d < 64; ++d) { q[d] = bf2f(qp[d]); o[d] = 0.f; }
            const float Ft = sF[t] * LOG2E;
            float mx = -INFINITY, l = 0.f;
            const int tmax = it * 512 + (tid | 63);
            for (int s = 0; s <= tmax; ++s) {
                const bf16* kp = F.QKVG + ((size_t)b * SEQ + s) * NQ + C_BK + 64 * h; const bf16* vp = kp + (C_BV - C_BK);
                float dot = 0.f;
#pragma unroll
                for (int d8 = 0; d8 < 8; ++d8) { const v4u kk = *(const v4u*)(kp + 8 * d8);
                    dot += q[8 * d8 + 0] * bflo(kk.x) + q[8 * d8 + 1] * bfhi(kk.x) + q[8 * d8 + 2] * bflo(kk.y) + q[8 * d8 + 3] * bfhi(kk.y)
                         + q[8 * d8 + 4] * bflo(kk.z) + q[8 * d8 + 5] * bfhi(kk.z) + q[8 * d8 + 6] * bflo(kk.w) + q[8 * d8 + 7] * bfhi(kk.w); }
                const float logit = dot + Ft - sF[s] * LOG2E;
                if (s <= t) {
                    if (logit > mx) { const float f = exp2f(mx - logit); l *= f;
#pragma unroll
                        for (int d = 0; d < 64; ++d) o[d] *= f;
                        mx = logit; }
                    const float p = exp2f(logit - mx); l += p;
#pragma unroll
                    for (int d8 = 0; d8 < 8; ++d8) { const v4u vv = *(const v4u*)(vp + 8 * d8);
                        o[8 * d8 + 0] += p * bflo(vv.x); o[8 * d8 + 1] += p * bfhi(vv.x); o[8 * d8 + 2] += p * bflo(vv.y); o[8 * d8 + 3] += p * bfhi(vv.y);
                        o[8 * d8 + 4] += p * bflo(vv.z); o[8 * d8 + 5] += p * bfhi(vv.z); o[8 * d8 + 6] += p * bflo(vv.w); o[8 * d8 + 7] += p * bfhi(vv.w); }
                }
            }
            const float rl = 1.0f / l;
            const bf16* gp = F.QKVG + m * NQ + C_G + 512 + 64 * h; bf16* yp = F.R2 + m * D + 512 + 64 * h;
#pragma unroll
            for (int d = 0; d < 64; ++d) { const float g = bf2f(gp[d]); yp[d] = (bf16)f2bf(o[d] * rl * g * sigmoidf_(g)); }
        }
        __syncthreads();
    }
    for (int it0 = F.vcu; it0 < BATCH * AKVH * 4; it0 += F.G) {
        const int pair = it0 >> 2, b = pair >> 1, kvh = pair & 1, t0 = (it0 & 3) * 512;
        __syncthreads();
        { const int g = tid >> 7, rel = tid & 127; sB[tid] = F.rel_bias[t5_bucket(rel) * AQH + kvh * 4 + g] * LOG2E; }
        __syncthreads();
        for (int g = 0; g < 4; ++g) {
            const int hq = kvh * 4 + g, t = t0 + tid; const size_t m = (size_t)b * SEQ + t;
            float q[64], o[64];
            const bf16* qp = F.QKVG + m * NQ + C_AQ + 64 * hq;
#pragma unroll
            for (int d = 0; d < 64; ++d) { q[d] = bf2f(qp[d]); o[d] = 0.f; }
            float mx = F.attn_sinks[hq] * LOG2E, l = 1.0f;
            for (int rel = 0; rel < WINDOW; ++rel) {
                const int s = t - rel;
                if (s >= 0) {
                    const bf16* kp = F.QKVG + ((size_t)b * SEQ + s) * NQ + C_AK + 64 * kvh; const bf16* vp = kp + (C_AV - C_AK);
                    float dot = 0.f;
#pragma unroll
                    for (int d8 = 0; d8 < 8; ++d8) { const v4u kk = *(const v4u*)(kp + 8 * d8);
                        dot += q[8 * d8 + 0] * bflo(kk.x) + q[8 * d8 + 1] * bfhi(kk.x) + q[8 * d8 + 2] * bflo(kk.y) + q[8 * d8 + 3] * bfhi(kk.y)
                             + q[8 * d8 + 4] * bflo(kk.z) + q[8 * d8 + 5] * bfhi(kk.z) + q[8 * d8 + 6] * bflo(kk.w) + q[8 * d8 + 7] * bfhi(kk.w); }
                    const float logit = dot + sB[g * 128 + rel];
                    if (logit > mx) { const float f = exp2f(mx - logit); l *= f;
#pragma unroll
                        for (int d = 0; d < 64; ++d) o[d] *= f;
                        mx = logit; }
                    const float p = exp2f(logit - mx); l += p;
#pragma unroll
                    for (int d8 = 0; d8 < 8; ++d8) { const v4u vv = *(const v4u*)(vp + 8 * d8);
                        o[8 * d8 + 0] += p * bflo(vv.x); o[8 * d8 + 1] += p * bfhi(vv.x); o[8 * d8 + 2] += p * bflo(vv.y); o[8 * d8 + 3] += p * bfhi(vv.y);
                        o[8 * d8 + 4] += p * bflo(vv.z); o[8 * d8 + 5] += p * bfhi(vv.z); o[8 * d8 + 6] += p * bflo(vv.w); o[8 * d8 + 7] += p * bfhi(vv.w); }
                }
            }
            const float rl = 1.0f / l;
            const bf16* gp = F.QKVG + m * NQ + C_G + 64 * hq; bf16* yp = F.R2 + m * D + 64 * hq;
#pragma unroll
            for (int d = 0; d < 64; ++d) { const float gg = bf2f(gp[d]); yp[d] = (bf16)f2bf(o[d] * rl * gg * sigmoidf_(gg)); }
        }
    }
    __syncthreads();
}
__device__ __forceinline__ void p5_naive(Frame& F) {
    LAS float* sXc = (LAS float*)(F.lds + RING_OFF);
    const int tid = F.tid, cl = tid >> 2, part = tid & 3;
    for (int item = F.vcu; item < BATCH * 8; item += F.G) {
        const int b = item >> 3, n = item & 7, c = n * 128 + cl;
        const float w0 = F.lru_conv_w[c], w1 = F.lru_conv_w[1024 + c], w2 = F.lru_conv_w[2048 + c], w3 = F.lru_conv_w[3072 + c], cb = F.lru_conv_b[c];
        const float ba = F.lru_b_a[c], bx = F.lru_b_x[c];
        const float lam = F.lru_lambda[c], sp = fmaxf(-lam, 0.f) + log1pf(expf(-fabsf(lam)));
        const bf16* wa = F.WAT + (size_t)n * 16384 + (size_t)cl * 128 + 32 * part; const bf16* wx = F.WXT + (size_t)n * 16384 + (size_t)cl * 128 + 32 * part;
        float wav[32], wxv[32];
#pragma unroll
        for (int i = 0; i < 32; ++i) { wav[i] = bf2f(wa[i]); wxv[i] = bf2f(wx[i]); }
        float xm1 = 0.f, xm2 = 0.f, xm3 = 0.f, hst = 0.f;
        __syncthreads();
        for (int t = 0; t < SEQ; ++t) {
            const size_t m = (size_t)b * SEQ + t;
            const float x0 = bf2f(F.XG[m * NXG + c]);
            const float xc = cb + w0 * xm3 + w1 * xm2 + w2 * xm1 + w3 * x0;
            xm3 = xm2; xm2 = xm1; xm1 = x0;
            LAS float* sx = sXc + (t & 1) * 128;
            if (part == 0) sx[cl] = xc;
            __syncthreads();
            float ra = 0.f, ia = 0.f;
#pragma unroll
            for (int i = 0; i < 32; ++i) { const float xv = sx[32 * part + i]; ra += xv * wav[i]; ia += xv * wxv[i]; }
            ra += __shfl_xor(ra, 1); ra += __shfl_xor(ra, 2); ia += __shfl_xor(ia, 1); ia += __shfl_xor(ia, 2);
            const float r = sigmoidf_(ra + ba), ig = sigmoidf_(ia + bx);
            const float log_a = -8.0f * r * sp, a = expf(log_a), mult = sqrtf(-expm1f(2.0f * log_a));
            hst = a * hst + mult * (ig * xc);
            if (part == 0) { const float g = bf2f(F.XG[m * NXG + 1024 + c]); F.R2[m * D + c] = (bf16)f2bf(hst * g * sigmoidf_(g)); }
        }
        __syncthreads();
    }
}

template <int EPI> __device__ __forceinline__ void naive_gemm(Frame& F, const bf16* A, const bf16* Bt, int N) {
    const int gw = F.vcu * NWAVES + F.wave, NGW = F.G * NWAVES, nch = N / 64;
    for (long it = gw; it < (long)M * nch; it += NGW) {
        const int m = (int)(it / nch), ch = (int)(it % nch), n = ch * 64 + F.lane, b = m / SEQ;
        const bf16* ap = A + (size_t)m * D; const bf16* bp = Bt + (size_t)n * D;
        float acc = 0.f;
        for (int k = 0; k < D; k += 8) { const v4u a = *(const v4u*)(ap + k), w = *(const v4u*)(bp + k);
            acc += bflo(a.x) * bflo(w.x) + bfhi(a.x) * bfhi(w.x) + bflo(a.y) * bflo(w.y) + bfhi(a.y) * bfhi(w.y) + bflo(a.z) * bflo(w.z) + bfhi(a.z) * bfhi(w.z) + bflo(a.w) * bflo(w.w) + bfhi(a.w) * bfhi(w.w); }
        if (EPI == 0) { const int pn = n >> 8; const float s = (pn == 0 || pn == 1 || pn == 3 || pn == 4) ? QSCALE : 1.f; F.QKVG[(size_t)m * NQ + n] = (bf16)f2bf(acc * s); }
        if (EPI == 1) { const float x1 = F.x[(size_t)m * D + n] + F.mod[(size_t)b * 3072 + 2048 + n] * acc; F.x1[(size_t)m * D + n] = x1;
            F.A1[(size_t)m * D + n] = (bf16)f2bf(x1 * F.gs[32 * 1024 + b * 1024 + n]); const float ss = wave_sum(x1 * x1); if (F.lane == 0) F.part[(size_t)m * 16 + ch] = ss; }
        if (EPI == 2) { float ps = F.part[(size_t)m * 16 + (F.lane & 15)]; ps += __shfl_xor(ps, 1); ps += __shfl_xor(ps, 2); ps += __shfl_xor(ps, 4); ps += __shfl_xor(ps, 8);
            const float rstd = 1.0f / sqrtf(ps * (1.0f / D) + EPS); F.XG[(size_t)m * NXG + n] = (bf16)f2bf(acc * rstd + F.sw1[(size_t)b * 2048 + n]); }
        if (EPI == 3) { const float x2 = F.x1[(size_t)m * D + n] + F.mod[(size_t)(32 + b) * 3072 + 2048 + n] * acc; F.out[(size_t)m * D + n] = x2;
            const float ss = wave_sum(x2 * x2); if (F.lane == 0) F.part2[(size_t)m * 16 + ch] = ss; }
    }
}

__device__ __forceinline__ float fast_sigmoid(float z) { return __builtin_amdgcn_rcpf(1.0f + __builtin_amdgcn_exp2f(-LOG2E * z)); }
__device__ __forceinline__ void p5_lru(Frame& F) {
    constexpr int XCP = 136, AUP = 132;
    constexpr int OFF_XC = 0, OFF_G = 17408, OFF_A = OFF_G + 2 * 16384, OFF_U = OFF_A + 64 * AUP * 4, OFF_COMB = OFF_U + 64 * AUP * 4, OFF_ST = OFF_COMB + 8192;
    static_assert(OFF_ST + 1024 <= RING_BYTES, "P5 LDS map");
    LAS unsigned char* L = F.lds + RING_OFF;
    LAS bf16* sXC = (LAS bf16*)(L + OFF_XC);
    LAS float* sA = (LAS float*)(L + OFF_A); LAS float* sU = (LAS float*)(L + OFF_U);
    LAS f32x4* sComb = (LAS f32x4*)(L + OFF_COMB); LAS float* sSt = (LAS float*)(L + OFF_ST);
    const int tid = F.tid, lane = F.lane, wave = F.wave;
    const int t2 = tid >> 4, c8 = tid & 15;
    const int v2 = 16 * wave + (lane & 15), q2 = lane >> 4;
    for (int item = F.vcu; item < BATCH * 8; item += F.G) {
        const int b = item >> 3, n = item & 7;
        float cw[4][8], cbv[8];
        { const int c0 = n * 128 + 8 * c8;
#pragma unroll
          for (int j = 0; j < 4; ++j) { const f32x4 lo = *(const f32x4*)(F.lru_conv_w + j * 1024 + c0), hi = *(const f32x4*)(F.lru_conv_w + j * 1024 + c0 + 4);
              cw[j][0] = lo[0]; cw[j][1] = lo[1]; cw[j][2] = lo[2]; cw[j][3] = lo[3]; cw[j][4] = hi[0]; cw[j][5] = hi[1]; cw[j][6] = hi[2]; cw[j][7] = hi[3]; }
          const f32x4 lo = *(const f32x4*)(F.lru_conv_b + c0), hi = *(const f32x4*)(F.lru_conv_b + c0 + 4);
          cbv[0] = lo[0]; cbv[1] = lo[1]; cbv[2] = lo[2]; cbv[3] = lo[3]; cbv[4] = hi[0]; cbv[5] = hi[1]; cbv[6] = hi[2]; cbv[7] = hi[3]; }
        const int cg2 = n * 128 + v2;
        const float ba2 = F.lru_b_a[cg2], bx2 = F.lru_b_x[cg2];
        float nsp8; { const float lam = F.lru_lambda[cg2]; nsp8 = -8.0f * (fmaxf(-lam, 0.f) + log1pf(expf(-fabsf(lam)))); }
        bf16x8 Br[4], Bi[4];
#pragma unroll
        for (int ks = 0; ks < 4; ++ks) { Br[ks] = *(const bf16x8*)(F.WAT + (size_t)n * 16384 + (size_t)v2 * 128 + 32 * ks + 8 * q2); Bi[ks] = *(const bf16x8*)(F.WXT + (size_t)n * 16384 + (size_t)v2 * 128 + 32 * ks + 8 * q2); }
        if (tid < 128) sSt[tid] = 0.f;
        const bf16* xbase = F.XG + (size_t)b * SEQ * NXG + n * 128 + 8 * c8;
        bf16* ybase = F.R2 + (size_t)b * SEQ * D + n * 128 + 2 * lane;
        v4u xrw[5], gv[2];
#pragma unroll
        for (int r = 0; r < 5; ++r) { const int tt = 2 * t2 - 3 + r; xrw[r] = (tt >= 0) ? *(const v4u*)(xbase + (size_t)tt * NXG) : (v4u){0u, 0u, 0u, 0u}; }
        gv[0] = *(const v4u*)(xbase + (size_t)(2 * t2) * NXG + 1024); gv[1] = *(const v4u*)(xbase + (size_t)(2 * t2 + 1) * NXG + 1024);
        __syncthreads();
        for (int ch = 0; ch < SEQ / 64; ++ch) {
            const int par = ch & 1, tb = ch * 64;
            LAS bf16* sG = (LAS bf16*)(L + OFF_G + par * 16384);
            {
                float xf[5][8];
#pragma unroll
                for (int r = 0; r < 5; ++r) { xf[r][0] = bflo(xrw[r].x); xf[r][1] = bfhi(xrw[r].x); xf[r][2] = bflo(xrw[r].y); xf[r][3] = bfhi(xrw[r].y); xf[r][4] = bflo(xrw[r].z); xf[r][5] = bfhi(xrw[r].z); xf[r][6] = bflo(xrw[r].w); xf[r][7] = bfhi(xrw[r].w); }
#pragma unroll
                for (int e = 0; e < 2; ++e) { float xc[8];
#pragma unroll
                    for (int j = 0; j < 8; ++j) xc[j] = cbv[j] + cw[0][j] * xf[e][j] + cw[1][j] * xf[e + 1][j] + cw[2][j] * xf[e + 2][j] + cw[3][j] * xf[e + 3][j];
                    v4u o; o.x = pk2(xc[0], xc[1]); o.y = pk2(xc[2], xc[3]); o.z = pk2(xc[4], xc[5]); o.w = pk2(xc[6], xc[7]);
                    *(LAS v4u*)(sXC + (2 * t2 + e) * XCP + 8 * c8) = o;
                    *(LAS v4u*)(sG + (2 * t2 + e) * 128 + 8 * c8) = gv[e]; }
            }
            __syncthreads();
            if (ch + 1 < SEQ / 64) {
#pragma unroll
                for (int r = 0; r < 5; ++r) xrw[r] = *(const v4u*)(xbase + (size_t)(tb + 64 + 2 * t2 - 3 + r) * NXG);
                gv[0] = *(const v4u*)(xbase + (size_t)(tb + 64 + 2 * t2) * NXG + 1024); gv[1] = *(const v4u*)(xbase + (size_t)(tb + 64 + 2 * t2 + 1) * NXG + 1024);
            }
#pragma unroll
            for (int jt = 0; jt < 4; ++jt) {
                f32x4 ar = {0.f, 0.f, 0.f, 0.f}, ai = {0.f, 0.f, 0.f, 0.f};
#pragma unroll
                for (int ks = 0; ks < 4; ++ks) { const bf16x8 af = *(const LAS bf16x8*)(sXC + (16 * jt + (lane & 15)) * XCP + 32 * ks + 8 * q2);
                    ar = __builtin_amdgcn_mfma_f32_16x16x32_bf16(af, Br[ks], ar, 0, 0, 0); ai = __builtin_amdgcn_mfma_f32_16x16x32_bf16(af, Bi[ks], ai, 0, 0, 0); }
#pragma unroll
                for (int r = 0; r < 4; ++r) { const int t = 16 * jt + 4 * q2 + r;
                    const float rg = fast_sigmoid(ar[r] + ba2), ig = fast_sigmoid(ai[r] + bx2);
                    const float la = rg * nsp8, a = __builtin_amdgcn_exp2f(LOG2E * la);
                    const float y = 2.0f * la;
                    const float om = -y * (1.0f + y * (0.5f + y * (0.16666667f + y * (0.041666668f + y * (0.0083333338f + y * 0.0013888889f)))));
                    const float xcv = bf2f(sXC[t * XCP + v2]);
                    sA[t * AUP + v2] = a; sU[t * AUP + v2] = __builtin_amdgcn_sqrtf(om) * (ig * xcv); }
            }
            __syncthreads();
            float P0[8], P1[8], h0[8], h1[8];
            { float p0 = 1.f, p1 = 1.f, g0 = 0.f, g1 = 0.f;
#pragma unroll
              for (int i = 0; i < 8; ++i) { const int t = 8 * wave + i; const f32x2 av = *(const LAS f32x2*)(sA + t * AUP + 2 * lane), uv = *(const LAS f32x2*)(sU + t * AUP + 2 * lane);
                  p0 *= av.x; p1 *= av.y; g0 = av.x * g0 + uv.x; g1 = av.y * g1 + uv.y; P0[i] = p0; P1[i] = p1; h0[i] = g0; h1[i] = g1; }
              sComb[wave * 64 + lane] = (f32x4){p0, p1, g0, g1}; }
            __syncthreads();
            { const f32x2 cs = *(const LAS f32x2*)(sSt + par * 128 + 2 * lane); float c0 = cs.x, c1 = cs.y;
              for (int w = 0; w < wave; ++w) { const f32x4 cm = sComb[w * 64 + lane]; c0 = cm[0] * c0 + cm[2]; c1 = cm[1] * c1 + cm[3]; }
#pragma unroll
              for (int i = 0; i < 8; ++i) { const int t = 8 * wave + i;
                  const float hh0 = h0[i] + P0[i] * c0, hh1 = h1[i] + P1[i] * c1;
                  const unsigned gw = *(const LAS unsigned*)(sG + t * 128 + 2 * lane); const float g0 = bflo(gw), g1 = bfhi(gw);
                  *(unsigned*)(ybase + (size_t)(tb + t) * D) = pk2(hh0 * g0 * fast_sigmoid(g0), hh1 * g1 * fast_sigmoid(g1));
                  if (i == 7 && wave == 7) *(LAS f32x2*)(sSt + (par ^ 1) * 128 + 2 * lane) = (f32x2){hh0, hh1}; }
            }
        }
        __syncthreads();
    }
}

typedef float f32x16 __attribute__((ext_vector_type(16)));
typedef short s16x4 __attribute__((ext_vector_type(4)));
typedef short v4i16_t __attribute__((ext_vector_type(4)));
constexpr int A_K = 0, A_V = 32768, A_STG = 65536, A_WSF = 98304, A_F = 100352, A_END = A_F + 8192;
static_assert(A_END <= RING_BYTES, "P2 LDS map");
__device__ __forceinline__ int crow(int r, int hi) { return (r & 3) + 8 * (r >> 2) + 4 * hi; }
__device__ __forceinline__ unsigned cvtpk(float lo, float hi) { typedef float f2 __attribute__((ext_vector_type(2))); typedef __bf16 b2 __attribute__((ext_vector_type(2))); f2 v = {lo, hi}; b2 b = __builtin_convertvector(v, b2); return __builtin_bit_cast(unsigned, b); }
__device__ __forceinline__ s16x4 vtr(const LAS unsigned char* p) { return __builtin_bit_cast(s16x4, __builtin_amdgcn_ds_read_tr16_b64_v4i16((LAS v4i16_t*)p)); }
__device__ __forceinline__ float half_max(float v) { auto rr = __builtin_amdgcn_permlane32_swap(__float_as_uint(v), __float_as_uint(v), false, false); return fmaxf(__uint_as_float(rr[0]), __uint_as_float(rr[1])); }
__device__ __forceinline__ float half_sum(float v) { auto rr = __builtin_amdgcn_permlane32_swap(__float_as_uint(v), __float_as_uint(v), false, false); return __uint_as_float(rr[0]) + __uint_as_float(rr[1]); }
#define MFMA32(a, b, c) __builtin_amdgcn_mfma_f32_32x32x16_bf16(a, b, c, 0, 0, 0)
__device__ __forceinline__ void dma16(const void* gsrc, LAS unsigned char* lds_wave_base) { __builtin_amdgcn_global_load_lds((const unsigned*)gsrc, (LAS unsigned*)lds_wave_base, 16, 0, 0); }
__device__ __forceinline__ void dma_kv_tile(const bf16* krow0, const bf16* vrow0, LAS unsigned char* kslot, LAS unsigned char* vslot, int wave, int lane) {
    dma16(krow0 + (size_t)lane * NQ + wave * 8, kslot + wave * 1024);
    dma16(vrow0 + (size_t)(16 * (wave & 3) + (lane >> 2)) * NQ + (wave >> 2) * 32 + (lane & 3) * 8, vslot + wave * 1024);
}
__device__ __forceinline__ void qkt(f32x16& x0, f32x16& x1, const LAS unsigned char* kslot, const bf16x8 (&qr)[4], int r32, int hi) {
    const LAS unsigned char* kb = kslot + hi * 1024 + r32 * 16;
#pragma unroll
    for (int d0 = 0; d0 < 4; ++d0) { const bf16x8 b0 = *(const LAS bf16x8*)(kb + d0 * 2048), b1 = *(const LAS bf16x8*)(kb + d0 * 2048 + 512);
        x0 = MFMA32(b0, qr[d0], x0); x1 = MFMA32(b1, qr[d0], x1); }
}
template <bool FIRST> __device__ __forceinline__ void softmax_pv(f32x16 (&o)[2], float& m, float& l, f32x16& x0, f32x16& x1, const LAS unsigned char* vslot, LAS float* wsf, int lane, int r32, int hi) {
    float a = fmaxf(x0[0], x1[0]);
#pragma unroll
    for (int r = 1; r < 16; ++r) a = fmaxf(a, fmaxf(x0[r], x1[r]));
    const float rm = half_max(a);
    if (FIRST) {
        m += rm;
#pragma unroll
        for (int r = 0; r < 16; ++r) { x0[r] -= rm; x1[r] -= rm; }
    } else if (__any(rm > 0.f)) {
        const float dl = fmaxf(rm, 0.f); m += dl;
#pragma unroll
        for (int r = 0; r < 16; ++r) { x0[r] -= dl; x1[r] -= dl; }
        const float f = __builtin_amdgcn_exp2f(-dl); l *= f;
        if (hi == 0) wsf[r32] = f;
        asm volatile("s_waitcnt lgkmcnt(0)" ::: "memory");
#pragma unroll
        for (int r = 0; r < 16; ++r) { const float fr = wsf[crow(r, hi)]; o[0][r] *= fr; o[1][r] *= fr; }
        asm volatile("s_waitcnt lgkmcnt(0)" ::: "memory");
    }
    float sacc = 0.f;
#pragma unroll
    for (int r = 0; r < 16; ++r) { x0[r] = __builtin_amdgcn_exp2f(x0[r]); x1[r] = __builtin_amdgcn_exp2f(x1[r]); sacc += x0[r] + x1[r]; }
    l += sacc;
    typedef unsigned u32x4_t __attribute__((ext_vector_type(4)));
    u32x4_t pw[4];
#pragma unroll
    for (int k = 0; k < 2; ++k)
#pragma unroll
        for (int e = 0; e < 4; ++e) { pw[k][e] = cvtpk(x0[8 * k + 2 * e], x0[8 * k + 2 * e + 1]); pw[2 + k][e] = cvtpk(x1[8 * k + 2 * e], x1[8 * k + 2 * e + 1]); }
    const LAS unsigned char* vp = vslot + ((lane >> 4) & 1) * 32 + (lane & 3) * 8 + (4 * hi + ((lane & 15) >> 2)) * 64;
#pragma unroll
    for (int dh = 0; dh < 2; ++dh)
#pragma unroll
        for (int ks = 0; ks < 4; ++ks) { const s16x4 lo = vtr(vp + dh * 4096 + ks * 1024), hh = vtr(vp + dh * 4096 + ks * 1024 + 512);
            const bf16x8 vf = {lo[0], lo[1], lo[2], lo[3], hh[0], hh[1], hh[2], hh[3]};
            o[dh] = MFMA32(__builtin_bit_cast(bf16x8, pw[ks]), vf, o[dh]); }
}
__device__ __forceinline__ void attn_epilogue(f32x16 (&o)[2], float l_part, LAS float* wsf, LAS float* stg, const bf16* gate_rows, bf16* y_rows, int lane, int r32, int hi) {
    const float lt = half_sum(l_part);
    if (hi == 0) wsf[32 + r32] = lt;
    asm volatile("s_waitcnt lgkmcnt(0)" ::: "memory");
    float rli[16];
#pragma unroll
    for (int r = 0; r < 16; ++r) rli[r] = __builtin_amdgcn_rcpf(wsf[32 + crow(r, hi)]);
#pragma unroll
    for (int dh = 0; dh < 2; ++dh) {
#pragma unroll
        for (int r = 0; r < 16; ++r) stg[crow(r, hi) * 32 + r32] = o[dh][r] * rli[r];
        asm volatile("s_waitcnt lgkmcnt(0)" ::: "memory");
#pragma unroll
        for (int it = 0; it < 2; ++it) { const int idx = it * 64 + lane, row = idx >> 2, ch = idx & 3;
            const f32x4 va = *(const LAS f32x4*)(stg + row * 32 + ch * 8), vb = *(const LAS f32x4*)(stg + row * 32 + ch * 8 + 4);
            const v4u gq = *(const v4u*)(gate_rows + (size_t)row * NQ + dh * 32 + ch * 8);
            const float g0 = bflo(gq.x), g1 = bfhi(gq.x), g2 = bflo(gq.y), g3 = bfhi(gq.y), g4 = bflo(gq.z), g5 = bfhi(gq.z), g6 = bflo(gq.w), g7 = bfhi(gq.w);
            v4u w; w.x = pk2(va[0] * g0 * fast_sigmoid(g0), va[1] * g1 * fast_sigmoid(g1)); w.y = pk2(va[2] * g2 * fast_sigmoid(g2), va[3] * g3 * fast_sigmoid(g3));
            w.z = pk2(vb[0] * g4 * fast_sigmoid(g4), vb[1] * g5 * fast_sigmoid(g5)); w.w = pk2(vb[2] * g6 * fast_sigmoid(g6), vb[3] * g7 * fast_sigmoid(g7));
            *(v4u*)(y_rows + (size_t)row * D + dh * 32 + ch * 8) = w; }
        asm volatile("s_waitcnt lgkmcnt(0)" ::: "memory");
    }
}
__device__ __forceinline__ void p2_attn(Frame& F) {
    LAS unsigned char* L = F.lds + RING_OFF;
    const int tid = F.tid, lane = F.lane, wave = F.wave, r32 = lane & 31, hi = lane >> 5;
    LAS float* wsf = (LAS float*)(L + A_WSF) + wave * 64;
    LAS float* stg = (LAS float*)(L + A_STG) + wave * 1024;
    LAS float* sF = (LAS float*)(L + A_F);
    for (int bh = F.vcu; bh < BATCH * BH; bh += F.G) {
        const int b = bh >> 3, h = bh & 7;
        __syncthreads();
        block_cumsum_2048(F.lf + (size_t)b * SEQ * 8 + h, 8, sF, (LAS float*)(L + A_WSF), tid, lane, wave);
        const bf16* Kh = F.QKVG + (size_t)b * SEQ * NQ + C_BK + 64 * h; const bf16* Vh = F.QKVG + (size_t)b * SEQ * NQ + C_BV + 64 * h;
        for (int qb = 0; qb < SEQ / 256; ++qb) {
            const int NT = 4 * (qb + 1), q0 = 256 * qb + 32 * wave;
            const bf16* Qw = F.QKVG + ((size_t)b * SEQ + q0) * NQ + C_BQ + 64 * h;
            bf16x8 qr[4];
#pragma unroll
            for (int d0 = 0; d0 < 4; ++d0) qr[d0] = *(const bf16x8*)(Qw + (size_t)r32 * NQ + d0 * 16 + hi * 8);
            const float fref2 = sF[256 * qb] * LOG2E;
            float m = 0.f, l = 0.f; f32x16 o[2]; o[0] = f32x16{}; o[1] = f32x16{};
            dma_kv_tile(Kh, Vh, L + A_K, L + A_V, wave, lane);
            __syncthreads();
            for (int j = 0; j < NT; ++j) {
                if (j + 1 < NT) dma_kv_tile(Kh + (size_t)(j + 1) * 64 * NQ, Vh + (size_t)(j + 1) * 64 * NQ, L + A_K + ((j + 1) & 1) * 8192, L + A_V + ((j + 1) & 1) * 8192, wave, lane);
                const int jb = j - (NT - 4);
                if (jb <= (wave >> 1)) {
                    const LAS unsigned char* kslot = L + A_K + (j & 1) * 8192; const LAS unsigned char* vslot = L + A_V + (j & 1) * 8192;
                    f32x16 x0, x1; const float cst = fref2 - m;
                    const LAS float* sFt = sF + 64 * j + 4 * hi;
#pragma unroll
                    for (int i = 0; i < 4; ++i) { const f32x4 f0 = *(const LAS f32x4*)(sFt + 8 * i), f1 = *(const LAS f32x4*)(sFt + 32 + 8 * i);
#pragma unroll
                        for (int e = 0; e < 4; ++e) { x0[4 * i + e] = __builtin_fmaf(f0[e], -LOG2E, cst); x1[4 * i + e] = __builtin_fmaf(f1[e], -LOG2E, cst); } }
                    qkt(x0, x1, kslot, qr, r32, hi);
                    if (jb == (wave >> 1)) {
                        const int qrel = 32 * wave + r32 - 64 * jb;
#pragma unroll
                        for (int r = 0; r < 16; ++r) { const int kv = crow(r, hi); if (kv > qrel) x0[r] = -INFINITY; if (kv + 32 > qrel) x1[r] = -INFINITY; }
                    }
                    if (j == 0) softmax_pv<true>(o, m, l, x0, x1, vslot, wsf, lane, r32, hi);
                    else softmax_pv<false>(o, m, l, x0, x1, vslot, wsf, lane, r32, hi);
                }
                __syncthreads();
            }
            attn_epilogue(o, l, wsf, stg, F.QKVG + ((size_t)b * SEQ + q0) * NQ + C_G + 512 + 64 * h, F.R2 + ((size_t)b * SEQ + q0) * D + 512 + 64 * h, lane, r32, hi);
        }
    }
    for (int it0 = F.vcu; it0 < BATCH * AKVH * 4; it0 += F.G) {
        const int pair = it0 >> 2, b = pair >> 1, kvh = pair & 1;
        __syncthreads();
        for (int idx = tid; idx < 4 * 384; idx += NWAVES * 64) { const int g = idx / 384, i = idx % 384, rel = i - 127;
            sF[idx] = (rel >= 0 && rel < WINDOW) ? F.rel_bias[t5_bucket(rel) * AQH + kvh * 4 + g] * LOG2E : -INFINITY; }
        const bf16* Kh = F.QKVG + (size_t)b * SEQ * NQ + C_AK + 64 * kvh; const bf16* Vh = F.QKVG + (size_t)b * SEQ * NQ + C_AV + 64 * kvh;
        for (int u = 0; u < 4; ++u) {
            const int qblk = (it0 & 3) * 4 + u, k0 = 128 * (qblk - 1);
            const int jlo_unit = (qblk == 0) ? 2 : 0;
            __syncthreads();
            for (int jt = jlo_unit; jt < 4; ++jt) dma_kv_tile(Kh + (ptrdiff_t)(k0 + 64 * jt) * NQ, Vh + (ptrdiff_t)(k0 + 64 * jt) * NQ, L + A_K + jt * 8192, L + A_V + jt * 8192, wave, lane);
            __syncthreads();
            for (int pass = 0; pass < 2; ++pass) {
                const int combo = pass * 8 + wave, g = combo >> 2, sb = combo & 3, hq = kvh * 4 + g;
                const int tok0 = 128 * qblk + 32 * sb;
                const bf16* Qw = F.QKVG + ((size_t)b * SEQ + tok0) * NQ + C_AQ + 64 * hq;
                bf16x8 qr[4];
#pragma unroll
                for (int d0 = 0; d0 < 4; ++d0) qr[d0] = *(const bf16x8*)(Qw + (size_t)r32 * NQ + d0 * 16 + hi * 8);
                float m = F.attn_sinks[hq] * LOG2E, l = (hi == 0) ? 1.0f : 0.0f; f32x16 o[2]; o[0] = f32x16{}; o[1] = f32x16{};
                const int jlo = ((sb >> 1) > jlo_unit) ? (sb >> 1) : jlo_unit, jhi = (sb >> 1) + 2;
                for (int jt = jlo; jt <= jhi; ++jt) {
                    const LAS float* tp = sF + g * 384 + (255 + 32 * sb + r32 - 64 * jt - 4 * hi - 59);
                    f32x16 x0, x1;
#pragma unroll
                    for (int r = 0; r < 16; ++r) { x0[r] = tp[59 - ((r & 3) + 8 * (r >> 2))] - m; x1[r] = tp[59 - 32 - ((r & 3) + 8 * (r >> 2))] - m; }
                    qkt(x0, x1, L + A_K + jt * 8192, qr, r32, hi);
                    softmax_pv<false>(o, m, l, x0, x1, L + A_V + jt * 8192, wsf, lane, r32, hi);
                }
                attn_epilogue(o, l, wsf, stg, F.QKVG + ((size_t)b * SEQ + tok0) * NQ + C_G + 64 * hq, F.R2 + ((size_t)b * SEQ + tok0) * D + 64 * hq, lane, r32, hi);
            }
        }
    }
    __syncthreads();
}

struct Args { const float* in[20]; float* out; unsigned char* ws; int ph_lo, ph_hi, li, pad; };
__global__ void __launch_bounds__(NWAVES * 64, 2) mk_fwd(Args args) {
    extern __shared__ __attribute__((aligned(16))) unsigned char lds[];
    Frame F;
    F.lds = (LAS unsigned char*)lds;
    F.MISC = (volatile LAS unsigned*)(F.lds + MISC_OFF);
    F.tid = threadIdx.x; F.lane = F.tid & 63; F.wave = __builtin_amdgcn_readfirstlane(F.tid >> 6);
    F.G = gridDim.x; { const int bx = blockIdx.x; F.vcu = (F.G % 8 == 0) ? (bx % 8) * (F.G / 8) + bx / 8 : bx; }
    unsigned char* ws = args.ws;
    F.ctl = (gu32*)(ws + WS_CTL);
    F.x = args.in[0]; F.c = args.in[1]; F.rel_bias = args.in[2]; F.norm_g = args.in[3]; F.ada_w = args.in[4]; F.ada_b = args.in[5]; F.attn_w_in = args.in[6]; F.attn_sinks = args.in[7];
    F.attn_b_f = args.in[8]; F.attn_w_out = args.in[9]; F.lru_w_in = args.in[10]; F.lru_conv_w = args.in[11]; F.lru_conv_b = args.in[12]; F.lru_w_a = args.in[13]; F.lru_b_a = args.in[14];
    F.lru_w_x = args.in[15]; F.lru_b_x = args.in[16]; F.lru_lambda = args.in[17]; F.lru_w_out = args.in[18]; F.final_g = args.in[19]; F.out = args.out;
    F.mod = (float*)(ws + WS_MOD); F.gs = (float*)(ws + WS_GS); F.sw1 = (float*)(ws + WS_SW1); F.part = (float*)(ws + WS_PART); F.part2 = (float*)(ws + WS_PART2); F.lf = (float*)(ws + WS_LF);
    F.x1 = (float*)(ws + WS_X1);
    F.W0T = (bf16*)(ws + WS_W0T); F.WO0T = (bf16*)(ws + WS_WO0T); F.W1T = (bf16*)(ws + WS_W1T); F.WO1T = (bf16*)(ws + WS_WO1T); F.WAT = (bf16*)(ws + WS_WAT); F.WXT = (bf16*)(ws + WS_WXT);
    F.R2 = (bf16*)(ws + WS_R2); F.QKVG = (bf16*)(ws + WS_R1); F.A1 = (bf16*)(ws + WS_A1); F.XG = (bf16*)(ws + WS_XG);
    for (int u = F.tid; u < (LDS_BYTES - LDSCTL_OFF) / 4; u += NWAVES * 64) ((LAS unsigned*)(F.lds + LDSCTL_OFF))[u] = 0u;
    __syncthreads();
    XcdBarrier bar; bar.bar = (unsigned*)(F.ctl + CW_BAR); bar.x = 0; bar.st = nullptr;
    if (N_LAUNCHES == 1) bar = xcd_barrier_post((unsigned*)(F.ctl + CW_BAR), F.MISC + 8);
    const int lo = args.ph_lo, hi = args.ph_hi;
#define IN(k) (lo <= (k) && (k) < hi)
#define SEAM(k) do { if (IN(k) && IN((k) + 1)) xcd_barrier(bar); } while (0)

    if (IN(0)) { p0a(F); SEAM(0); }
    if (IN(1)) { p0b(F); SEAM(1); }
    if (IN(2)) {
        pg8::Gemm g{F.R2, F.W0T, M, NQ, D}; pg8::StaticOrder S; S.init(M, NQ, F.G, (int)blockIdx.x);
        pg8::EpiQKVG E{F.QKVG, NQ, (1u << 0) | (1u << 1) | (1u << 3) | (1u << 4), QSCALE};
#if GEMM_NAIVE & 1
        naive_gemm<0>(F, F.R2, F.W0T, NQ); (void)g; (void)S; (void)E;
#else
        pg8::gemm_phase<pg8::EpiQKVG, pg8::StaticOrder, true, true>(F.lds + RING_OFF, g, S, E);
#endif
        SEAM(2);
    }
    if (IN(3)) {
#if P2_NAIVE
        p2_naive(F);
#else
        p2_attn(F);
#endif
        SEAM(3);
    }
    if (IN(4)) {
        pg8::Gemm g{F.R2, F.WO0T, M, D, D}; pg8::StaticOrder S; S.init(M, D, F.G, (int)blockIdx.x);
        pg8::EpiRes0 E0{F.x, F.x1, F.A1, F.mod + 2048, 3072, F.gs + 32 * 1024, 1024, F.part};
#if GEMM_NAIVE & 2
        naive_gemm<1>(F, F.R2, F.WO0T, D); (void)g; (void)S; (void)E0;
#else
        pg8::gemm_phase<pg8::EpiRes0, pg8::StaticOrder, true, true>(F.lds + RING_OFF, g, S, E0);
#endif
        SEAM(4);
    }
    if (IN(5)) {
        pg8::Gemm g{F.A1, F.W1T, M, NXG, D}; pg8::StaticOrder S; S.init(M, NXG, F.G, (int)blockIdx.x);
        pg8::EpiXG E{F.XG, NXG, F.part, F.sw1, 2048, EPS};
#if GEMM_NAIVE & 4
        naive_gemm<2>(F, F.A1, F.W1T, NXG); (void)g; (void)S; (void)E;
#else
        pg8::gemm_phase<pg8::EpiXG, pg8::StaticOrder, true, true>(F.lds + RING_OFF, g, S, E);
#endif
        SEAM(5);
    }
    if (IN(6)) {
#if P5_NAIVE
        p5_naive(F);
#else
        p5_lru(F);
#endif
        SEAM(6);
    }
    if (IN(7)) {
        pg8::Gemm g{F.R2, F.WO1T, M, D, D}; pg8::StaticOrder S; S.init(M, D, F.G, (int)blockIdx.x);
        pg8::EpiRes1 E{F.x1, F.out, nullptr, F.mod + (size_t)32 * 3072 + 2048, 3072, nullptr, 0, F.part2};
#if GEMM_NAIVE & 8
        naive_gemm<3>(F, F.R2, F.WO1T, D); (void)g; (void)S; (void)E;
#else
        pg8::gemm_phase<pg8::EpiRes1, pg8::StaticOrder, true, true>(F.lds + RING_OFF, g, S, E);
#endif
        SEAM(7);
    }
    if (IN(8)) { p7(F); }
#undef IN
#undef SEAM
}

extern "C" void kernel_launch(void* const* d_in, const int* in_sizes, int n_in, void* d_out, int out_size, void* d_ws, size_t ws_size, hipStream_t stream) {
    static int grid = 0;
    if (grid == 0) {
        if (n_in != 20 || in_sizes[0] != M * D || out_size != M * D || ws_size < WS_END) { fprintf(stderr, "kernel_launch: unexpected shapes (n_in %d, in0 %d, out %d, ws %zu)\n", n_in, n_in > 0 ? in_sizes[0] : -1, out_size, ws_size); grid = -1; return; }
        int dev = 0, cus = 0;
        if (hipGetDevice(&dev) != hipSuccess || hipDeviceGetAttribute(&cus, hipDeviceAttributeMultiprocessorCount, dev) != hipSuccess) { grid = -1; return; }
        if (hipFuncSetAttribute((const void*)mk_fwd, hipFuncAttributeMaxDynamicSharedMemorySize, LDS_BYTES) != hipSuccess) { fprintf(stderr, "kernel_launch: hipFuncSetAttribute failed\n"); grid = -1; return; }
        (void)hipGetLastError();
        grid = cus;
    }
    if (grid < 0) return;
    if (hipMemsetAsync((char*)d_ws + WS_CTL, 0, CTL_ZERO_BYTES, stream) != hipSuccess) return;
    Args a{};
    for (int i = 0; i < 20; ++i) a.in[i] = (const float*)d_in[i];
    a.out = (float*)d_out; a.ws = (unsigned char*)d_ws;
    for (int li = 0; li < N_LAUNCHES; ++li) {
        a.ph_lo = (N_LAUNCHES == 1) ? 0 : li; a.ph_hi = (N_LAUNCHES == 1) ? N_PHASES : li + 1; a.li = li;
        hipLaunchKernelGGL(mk_fwd, dim3(grid), dim3(NWAVES * 64), LDS_BYTES, stream, a);
    }
}
```

```cpp
#include <hip/hip_runtime.h>
#include <cstdio>
#include <cstdint>
#include <cmath>
namespace pg8 {
#define PG8_LAS __attribute__((address_space(3)))
typedef unsigned short bf16_t;
typedef short bf16x8 __attribute__((ext_vector_type(8)));
typedef float f32x4 __attribute__((ext_vector_type(4)));
typedef unsigned u32x4 __attribute__((ext_vector_type(4)));
constexpr int BM = 256, BK = 64, HALF = 128, HTB = HALF * BK * 2  , STAGE_BYTES = 8 * HTB, NXCD = 8, WGM = 8;

__host__ __device__ __forceinline__ int lds_byte(int r, int c) { const int st = (r >> 4) * 2 + (c >> 5), rr = r & 15, cc = c & 31, ob = rr * 64 + cc * 2; return st * 1024 + (ob ^ (((ob >> 9) & 1) << 5)); }
__host__ __device__ __forceinline__ void stage_rc(int b, int& R, int& C) { const int st = b / 1024, sb = b % 1024, swz = sb ^ (((sb >> 9) & 1) << 5); R = (st >> 1) * 16 + swz / 64; C = (st & 1) * 32 + (swz % 64) / 2; }
__host__ __device__ __forceinline__ int perm32(int rho) { const int n = rho >> 4, i = rho & 15; return 8 * (i >> 2) + 4 * n + (i & 3); }

struct Unit { int pm, pn; };
struct Gemm { const bf16_t* A; const bf16_t* Bt; int M, N, K; };

struct StaticOrder {
    int nM, nN, nwg, G, c, rep;
    __host__ __device__ void init(int M, int N, int G_, int c_) { nM = M / BM; nN = N / BM; nwg = nM * nN; G = G_; c = c_; rep = 1; }
    __host__ __device__ bool next(int i, Unit& u) const {
        const long L = (long)i * G + c; if (L >= (long)nwg * rep) return false;
        int wgid = (int)(L % nwg); { const int q = nwg / NXCD, r = nwg % NXCD, xcd = wgid % NXCD, off = wgid / NXCD; wgid = (xcd < r ? xcd * (q + 1) : r * (q + 1) + (xcd - r) * q) + off; }
        const int nig = WGM * nN, gid = wgid / nig, fm = gid * WGM, gsz = (nM - fm) < WGM ? (nM - fm) : WGM;
        u.pm = fm + ((wgid % nig) % gsz); u.pn = (wgid % nig) / gsz; return true;
    }
    __device__ __forceinline__ void a_ready(const Unit&) const {}
    __device__ __forceinline__ void done(const Unit&) const {}
};

__device__ __forceinline__ unsigned cvt_pk_bf16(float lo, float hi) { unsigned r; asm volatile("v_cvt_pk_bf16_f32 %0, %1, %2" : "=v"(r) : "v"(lo), "v"(hi)); return r; }
struct EpiQKVG {
    static constexpr bool PERM = true, AFTER_DRAIN = false, HAS_INIT = false;
    bf16_t* O; int ldc; unsigned scale_mask; float sc;
    __device__ __forceinline__ void operator()(const f32x4 (&acc)[2][2][4][2], const Unit& u, int wr, int wc, int fr, int fq) const {
        const float s = ((scale_mask >> u.pn) & 1u) ? sc : 1.f;
        const int row0 = u.pm * BM + wr * 64 + fr, col0 = u.pn * BM + wc * 32 + 8 * fq;
#pragma unroll
        for (int ai = 0; ai < 2; ++ai)
#pragma unroll
            for (int m = 0; m < 4; ++m) { bf16_t* rowp = O + (size_t)(row0 + ai * HALF + m * 16) * ldc + col0;
#pragma unroll
                for (int bj = 0; bj < 2; ++bj) { const f32x4 v0 = acc[ai][bj][m][0] * s, v1 = acc[ai][bj][m][1] * s;
                    u32x4 w; w.x = cvt_pk_bf16(v0[0], v0[1]); w.y = cvt_pk_bf16(v0[2], v0[3]); w.z = cvt_pk_bf16(v1[0], v1[1]); w.w = cvt_pk_bf16(v1[2], v1[3]);
                    *(u32x4*)(rowp + bj * HALF) = w; } }
    }
};
template <bool WITH_A> struct EpiRes {
    static constexpr bool PERM = true, AFTER_DRAIN = false, HAS_INIT = false;
    const float* XI; float* XO; bf16_t* AO; const float* gm; int gmp; const float* gs; int gsp; float* part;
    __device__ __forceinline__ void operator()(const f32x4 (&acc)[2][2][4][2], const Unit& u, int wr, int wc, int fr, int fq) const {
        const int b = u.pm >> 3;
        const int col0 = u.pn * BM + wc * 32 + 8 * fq;
        f32x4 gmv[2][2], gsv[2][2];
#pragma unroll
        for (int bj = 0; bj < 2; ++bj)
#pragma unroll
            for (int n = 0; n < 2; ++n) { gmv[bj][n] = *(const f32x4*)(gm + (size_t)b * gmp + col0 + bj * HALF + 4 * n);
                if (WITH_A) gsv[bj][n] = *(const f32x4*)(gs + (size_t)b * gsp + col0 + bj * HALF + 4 * n); }
#pragma unroll
        for (int ai = 0; ai < 2; ++ai)
#pragma unroll
            for (int m = 0; m < 4; ++m) { const int row = u.pm * BM + ai * HALF + wr * 64 + m * 16 + fr; const size_t off = (size_t)row * 1024 + col0;
                float ss = 0.f;
#pragma unroll
                for (int bj = 0; bj < 2; ++bj) {
                    const f32x4 xa = *(const f32x4*)(XI + off + bj * HALF), xb = *(const f32x4*)(XI + off + bj * HALF + 4);
                    const f32x4 o0 = xa + gmv[bj][0] * acc[ai][bj][m][0], o1 = xb + gmv[bj][1] * acc[ai][bj][m][1];
                    *(f32x4*)(XO + off + bj * HALF) = o0; *(f32x4*)(XO + off + bj * HALF + 4) = o1;
                    ss += (o0[0] * o0[0] + o0[1] * o0[1]) + (o0[2] * o0[2] + o0[3] * o0[3]) + (o1[0] * o1[0] + o1[1] * o1[1]) + (o1[2] * o1[2] + o1[3] * o1[3]);
                    if (WITH_A) { const f32x4 a0 = o0 * gsv[bj][0], a1 = o1 * gsv[bj][1];
                        u32x4 w; w.x = cvt_pk_bf16(a0[0], a0[1]); w.y = cvt_pk_bf16(a0[2], a0[3]); w.z = cvt_pk_bf16(a1[0], a1[1]); w.w = cvt_pk_bf16(a1[2], a1[3]);
                        *(u32x4*)(AO + off + bj * HALF) = w; } }
                ss += __shfl_xor(ss, 16); ss += __shfl_xor(ss, 32);
                if (fq == 0) part[(size_t)row * 16 + u.pn * 4 + wc] = ss;
                if (m & 1) asm volatile("" ::: "memory"); }
    }
};
struct EpiXG {
    static constexpr bool PERM = true, AFTER_DRAIN = false, HAS_INIT = false;
    bf16_t* O; int ldc; const float* part; const float* sw; int swpitch; float eps;
    __device__ __forceinline__ void operator()(const f32x4 (&acc)[2][2][4][2], const Unit& u, int wr, int wc, int fr, int fq) const {
        const int b = u.pm >> 3;
        const int col0 = u.pn * BM + wc * 32 + 8 * fq;
        f32x4 swv[2][2];
#pragma unroll
        for (int bj = 0; bj < 2; ++bj)
#pragma unroll
            for (int n = 0; n < 2; ++n) swv[bj][n] = *(const f32x4*)(sw + (size_t)b * swpitch + col0 + bj * HALF + 4 * n);
        float rstd[2][4];
#pragma unroll
        for (int ai = 0; ai < 2; ++ai)
#pragma unroll
            for (int m = 0; m < 4; ++m) { const int row = u.pm * BM + ai * HALF + wr * 64 + m * 16 + fr;
                const f32x4* pp = (const f32x4*)(part + (size_t)row * 16); const f32x4 p0 = pp[0], p1 = pp[1], p2 = pp[2], p3 = pp[3];
                const float ssum = ((p0[0] + p0[1]) + (p0[2] + p0[3])) + ((p1[0] + p1[1]) + (p1[2] + p1[3])) + ((p2[0] + p2[1]) + (p2[2] + p2[3])) + ((p3[0] + p3[1]) + (p3[2] + p3[3]));
                rstd[ai][m] = 1.0f / sqrtf(ssum * (1.0f / 1024.0f) + eps); }
        asm volatile("" ::: "memory");
#pragma unroll
        for (int ai = 0; ai < 2; ++ai)
#pragma unroll
            for (int m = 0; m < 4; ++m) { const int row = u.pm * BM + ai * HALF + wr * 64 + m * 16 + fr; const float rs = rstd[ai][m];
                bf16_t* rowp = O + (size_t)row * ldc + col0;
#pragma unroll
                for (int bj = 0; bj < 2; ++bj) { const f32x4 v0 = acc[ai][bj][m][0] * rs + swv[bj][0], v1 = acc[ai][bj][m][1] * rs + swv[bj][1];
                    u32x4 w; w.x = cvt_pk_bf16(v0[0], v0[1]); w.y = cvt_pk_bf16(v0[2], v0[3]); w.z = cvt_pk_bf16(v1[0], v1[1]); w.w = cvt_pk_bf16(v1[2], v1[3]);
                    *(u32x4*)(rowp + bj * HALF) = w; } }
    }
};
typedef EpiRes<true> EpiRes0; typedef EpiRes<false> EpiRes1;
template <class Epi, class Sched, bool ALIGN_EPI = false, bool SP2 = false>
__device__ __forceinline__ void gemm_phase(PG8_LAS unsigned char* lds, const Gemm g, const Sched& S, const Epi& E) {
    const int tid = threadIdx.x, wid = __builtin_amdgcn_readfirstlane(tid >> 6), lane = tid & 63, wr = wid >> 2, wc = wid & 3, fr = lane & 15, fq = lane >> 4;
    const int K = g.K, nt = K / BK;
    unsigned voffA[2], voffB[2];
#pragma unroll
    for (int i = 0; i < 2; ++i) { int R, C; stage_rc(tid * 16 + i * 8192, R, C); const int Rb = Epi::PERM ? ((R & ~31) + perm32(R & 31)) : R;
        voffA[i] = (unsigned)(R * K + C) * 2u; voffB[i] = (unsigned)(Rb * K + C) * 2u; }
    const size_t kstep = (size_t)(BK * 2);
    const size_t hstep = (size_t)HALF * K * 2;
    const size_t tstep = 2 * hstep;
    const unsigned ldsw = (unsigned)wid * 1024u;
    const int aoff = lds_byte(wr * 64 + fr, fq * 8), boff = lds_byte(wc * 32 + fr, fq * 8);
#define PG8_SA(b, h) (((b) * 2 + (h)) * HTB)
#define PG8_SB(b, h) ((4 + (b) * 2 + (h)) * HTB)
#define PG8_STAGE(bufoff, gbase, voff) do { _Pragma("unroll") for (int _i = 0; _i < 2; ++_i) \
        __builtin_amdgcn_global_load_lds((const unsigned*)((const char*)(gbase) + (voff)[_i]), (PG8_LAS unsigned*)(lds + (bufoff) + ldsw + _i * 8192), 16, 0, 0); } while (0)
#define PG8_LDA(dst, b, h) do { _Pragma("unroll") for (int m = 0; m < 4; ++m) _Pragma("unroll") for (int k = 0; k < 2; ++k) dst[m][k] = *(const PG8_LAS bf16x8*)(lds + PG8_SA(b, h) + aoff + m * 2048 + k * 1024); } while (0)
#define PG8_LDB(dst, b, h) do { _Pragma("unroll") for (int n = 0; n < 2; ++n) _Pragma("unroll") for (int k = 0; k < 2; ++k) dst[n][k] = *(const PG8_LAS bf16x8*)(lds + PG8_SB(b, h) + boff + n * 2048 + k * 1024); } while (0)
#define PG8_MMA(ai, bj, At, Bt) do { __builtin_amdgcn_s_setprio(1); _Pragma("unroll") for (int m = 0; m < 4; ++m) _Pragma("unroll") for (int n = 0; n < 2; ++n) _Pragma("unroll") for (int k = 0; k < 2; ++k) \
        acc[ai][bj][m][n] = __builtin_amdgcn_mfma_f32_16x16x32_bf16(Bt[n][k], At[m][k], acc[ai][bj][m][n], 0, 0, 0); __builtin_amdgcn_s_setprio(0); } while (0)
#define PG8_WAIT_V(n) asm volatile("s_waitcnt vmcnt(" #n ")" ::: "memory")
#define PG8_WAIT_L(n) asm volatile("s_waitcnt lgkmcnt(" #n ")" ::: "memory")
#define PG8_BAR __builtin_amdgcn_s_barrier()
#define PG8_SCHED __builtin_amdgcn_sched_barrier(0)
    Unit cur, nxt; int ui = 0;
    if (!S.next(0, cur)) return;
    f32x4 acc[2][2][4][2];
    if constexpr (Epi::HAS_INIT) E.init(acc, cur, wr, wc, fr, fq);
    else {
#pragma unroll
    for (int a = 0; a < 2; ++a)
#pragma unroll
        for (int b = 0; b < 2; ++b)
#pragma unroll
            for (int m = 0; m < 4; ++m)
#pragma unroll
                for (int n = 0; n < 2; ++n) acc[a][b][m][n] = (f32x4){0.f, 0.f, 0.f, 0.f};
    }
    bf16x8 At[4][2], B0[2][2], B1[2][2];
    const char* cA = (const char*)g.A + (size_t)cur.pm * tstep; const char* cB = (const char*)g.Bt + (size_t)cur.pn * tstep;
    S.a_ready(cur);
    if constexpr (SP2) {
        PG8_STAGE(PG8_SB(0, 0), cB, voffB); PG8_STAGE(PG8_SB(0, 1), cB + hstep, voffB); PG8_STAGE(PG8_SA(0, 0), cA, voffA); PG8_STAGE(PG8_SA(0, 1), cA + hstep, voffA);
        if (wr == 1) PG8_BAR;
        PG8_WAIT_V(2); PG8_BAR;
        PG8_STAGE(PG8_SB(1, 0), cB + kstep, voffB); PG8_STAGE(PG8_SA(1, 0), cA + kstep, voffA); PG8_STAGE(PG8_SB(1, 1), cB + hstep + kstep, voffB);
        PG8_WAIT_V(6); PG8_BAR;
    } else {
        PG8_STAGE(PG8_SB(0, 0), cB, voffB); PG8_STAGE(PG8_SA(0, 0), cA, voffA); PG8_STAGE(PG8_SB(0, 1), cB + hstep, voffB); PG8_STAGE(PG8_SA(0, 1), cA + hstep, voffA);
        if (wr == 1) PG8_BAR;
        PG8_WAIT_V(4); PG8_BAR;
        PG8_STAGE(PG8_SB(1, 0), cB + kstep, voffB); PG8_STAGE(PG8_SA(1, 0), cA + kstep, voffA); PG8_STAGE(PG8_SB(1, 1), cB + hstep + kstep, voffB);
        PG8_WAIT_V(6); PG8_BAR;
    }
    for (;;) {
        const bool has_next = S.next(ui + 1, nxt);
        const char* nA = has_next ? (const char*)g.A + (size_t)nxt.pm * tstep : cA; const char* nB = has_next ? (const char*)g.Bt + (size_t)nxt.pn * tstep : cB;
        for (int t = 0; t < nt; t += 2) {
            const bool last = (t == nt - 2);
            const char* a1 = cA + (size_t)(t + 1) * kstep;
            const char* a2 = last ? nA : cA + (size_t)(t + 2) * kstep; const char* b2 = last ? nB : cB + (size_t)(t + 2) * kstep;
            const char* a3 = a2 + kstep; const char* b3 = b2 + kstep;
            if (last && has_next) S.a_ready(nxt);
            if constexpr (SP2) {
            PG8_LDB(B0, 0, 0); PG8_LDB(B1, 0, 1); PG8_SCHED; PG8_LDA(At, 0, 0); PG8_STAGE(PG8_SA(1, 1), a1 + hstep, voffA);
            PG8_WAIT_V(8); PG8_WAIT_L(0); PG8_BAR; PG8_MMA(0, 0, At, B0); PG8_MMA(0, 1, At, B1); PG8_BAR; PG8_SCHED;
            PG8_LDA(At, 0, 1); PG8_STAGE(PG8_SB(0, 0), b2, voffB); PG8_STAGE(PG8_SB(0, 1), b2 + hstep, voffB); PG8_STAGE(PG8_SA(0, 0), a2, voffA);
            PG8_WAIT_V(8); PG8_WAIT_L(0); PG8_BAR; PG8_MMA(1, 0, At, B0); PG8_MMA(1, 1, At, B1); PG8_BAR; PG8_SCHED;
            PG8_LDB(B0, 1, 0); PG8_LDB(B1, 1, 1); PG8_SCHED; PG8_LDA(At, 1, 0); PG8_STAGE(PG8_SA(0, 1), a2 + hstep, voffA);
            PG8_WAIT_V(8); PG8_WAIT_L(0); PG8_BAR; PG8_MMA(0, 0, At, B0); PG8_MMA(0, 1, At, B1); PG8_BAR; PG8_SCHED;
            PG8_LDA(At, 1, 1); PG8_STAGE(PG8_SB(1, 0), b3, voffB); PG8_STAGE(PG8_SB(1, 1), b3 + hstep, voffB); PG8_STAGE(PG8_SA(1, 0), a3, voffA);
            PG8_WAIT_V(8); PG8_WAIT_L(0); PG8_BAR; PG8_MMA(1, 0, At, B0); PG8_MMA(1, 1, At, B1); PG8_BAR; PG8_SCHED;
            } else {
            PG8_LDB(B0, 0, 0); PG8_SCHED; PG8_LDA(At, 0, 0); PG8_STAGE(PG8_SA(1, 1), a1 + hstep, voffA);
            PG8_WAIT_L(8); PG8_BAR; PG8_WAIT_L(0); PG8_MMA(0, 0, At, B0); PG8_BAR; PG8_SCHED;
            PG8_LDB(B1, 0, 1); PG8_STAGE(PG8_SB(0, 0), b2, voffB);
            PG8_BAR; PG8_WAIT_L(0); PG8_MMA(0, 1, At, B1); PG8_BAR;
            PG8_LDA(At, 0, 1); PG8_STAGE(PG8_SA(0, 0), a2, voffA);
            PG8_BAR; PG8_WAIT_L(0); PG8_MMA(1, 0, At, B0); PG8_BAR; PG8_SCHED;
            PG8_STAGE(PG8_SB(0, 1), b2 + hstep, voffB);
            PG8_WAIT_V(6); PG8_BAR; PG8_MMA(1, 1, At, B1); PG8_BAR;
            PG8_LDB(B0, 1, 0); PG8_SCHED; PG8_LDA(At, 1, 0); PG8_STAGE(PG8_SA(0, 1), a2 + hstep, voffA);
            PG8_WAIT_L(8); PG8_BAR; PG8_WAIT_L(0); PG8_MMA(0, 0, At, B0); PG8_BAR; PG8_SCHED;
            PG8_LDB(B1, 1, 1); PG8_STAGE(PG8_SB(1, 0), b3, voffB);
            PG8_BAR; PG8_WAIT_L(0); PG8_MMA(0, 1, At, B1); PG8_BAR;
            PG8_LDA(At, 1, 1); PG8_STAGE(PG8_SA(1, 0), a3, voffA);
            PG8_BAR; PG8_WAIT_L(0); PG8_MMA(1, 0, At, B0); PG8_BAR; PG8_SCHED;
            PG8_STAGE(PG8_SB(1, 1), b3 + hstep, voffB);
            PG8_WAIT_V(6); PG8_BAR; PG8_MMA(1, 1, At, B1); PG8_BAR;
            }
        }
        if constexpr (ALIGN_EPI) { if (wr == 0) PG8_BAR; }
        if constexpr (!Epi::AFTER_DRAIN) { E(acc, cur, wr, wc, fr, fq); S.done(cur); }
        if (!has_next) break;
        if constexpr (Epi::HAS_INIT) E.init(acc, nxt, wr, wc, fr, fq);
        else {
#pragma unroll
        for (int a = 0; a < 2; ++a)
#pragma unroll
            for (int b = 0; b < 2; ++b)
#pragma unroll
                for (int m = 0; m < 4; ++m)
#pragma unroll
                    for (int n = 0; n < 2; ++n) acc[a][b][m][n] = (f32x4){0.f, 0.f, 0.f, 0.f};
        }
        cur = nxt; cA = nA; cB = nB; ++ui;
        if constexpr (ALIGN_EPI) { if (wr == 1) PG8_BAR; }
    }
    PG8_WAIT_V(0);
    if constexpr (!ALIGN_EPI) { if (wr == 0) PG8_BAR; }
    PG8_BAR;
    if constexpr (Epi::AFTER_DRAIN) { E.fused(acc, cur, wr, wc, fr, fq, lds, wid, lane); S.done(cur); }
#undef PG8_SA
#undef PG8_SB
#undef PG8_STAGE
#undef PG8_LDA
#undef PG8_LDB
#undef PG8_MMA
#undef PG8_WAIT_V
#undef PG8_WAIT_L
#undef PG8_BAR
#undef PG8_SCHED
}
}

constexpr int NWAVES = 8;
#ifndef MK_N_LAUNCHES
#define MK_N_LAUNCHES 1
#endif
constexpr int N_PHASES = 9;
constexpr int N_LAUNCHES = MK_N_LAUNCHES;
#ifndef GEMM_NAIVE
#define GEMM_NAIVE 0
#endif
#ifndef STAGGER_P3
#define STAGGER_P3 0
#endif
#ifndef STAGGER_P6
#define STAGGER_P6 0
#endif
#ifndef TIMING
#define TIMING 0
#endif
#ifndef TSEL
#define TSEL 1
#endif
#ifndef TIMING_CU
#define TIMING_CU 0
#endif
#ifndef TIMING_WAVE
#define TIMING_WAVE 0
#endif
#ifndef PHASE_TIMING
#define PHASE_TIMING 0
#endif
#ifndef PT_A
#define PT_A 0
#endif
#ifndef PT_B
#define PT_B 1
#endif
#ifndef REPEAT_MASK
#define REPEAT_MASK 0
#endif
#ifndef P2_NAIVE
#define P2_NAIVE 0
#endif
#ifndef P5_NAIVE
#define P5_NAIVE 0
#endif

constexpr int BATCH = 32, SEQ = 2048, D = 1024, M = BATCH * SEQ;
constexpr int HD = 64, AQH = 8, AKVH = 2, BH = 8, WINDOW = 128;
constexpr int ATTN_IN = 3336, NQ = 3328;
constexpr int C_AQ = 0, C_AK = 512, C_AV = 640, C_BQ = 768, C_BK = 1280, C_BV = 1792, C_G = 2304;
constexpr int LRU_W = 1024, NXG = 2048;
constexpr float EPS = 1e-6f, LOG2E = 1.4426950408889634f, QSCALE = 0.125f * 1.4426950408889634f;

constexpr size_t MiB = 1u << 20;
constexpr size_t WS_CTL = 0, CTL_ZERO_BYTES = 1 * MiB;
constexpr size_t WS_MOD = 1 * MiB;
constexpr size_t WS_GS = WS_MOD + 768 * 1024;
constexpr size_t WS_SW1 = 2 * MiB;
constexpr size_t WS_PART = 3 * MiB, WS_PART2 = 7 * MiB;
constexpr size_t WS_LF = 11 * MiB;
constexpr size_t WS_W0T = 16 * MiB, WS_WO0T = 23 * MiB, WS_W1T = 25 * MiB, WS_WO1T = 29 * MiB, WS_WAT = 31 * MiB, WS_WXT = WS_WAT + 256 * 1024;
constexpr size_t WS_R2 = 32 * MiB;
constexpr size_t WS_X1 = 160 * MiB;
constexpr size_t WS_R1 = 416 * MiB;
constexpr size_t WS_A1 = WS_R1, WS_XG = WS_R1 + 128 * MiB;
constexpr size_t WS_END = 832 * MiB;
static_assert(WS_W0T + (size_t)NQ * D * 2 <= WS_WO0T && WS_XG + (size_t)M * NXG * 2 <= WS_END && WS_R1 + (size_t)M * NQ * 2 <= WS_END, "ws map");
constexpr int CW_BAR = 4096;

constexpr int RING_OFF = 0, RING_BYTES = 131072;
constexpr int LDSCTL_OFF = RING_BYTES, MISC_OFF = LDSCTL_OFF + 320;
constexpr int LDS_BYTES = 147456;

#define GAS __attribute__((address_space(1)))
#define LAS __attribute__((address_space(3)))
typedef unsigned short bf16;
typedef unsigned v4u __attribute__((ext_vector_type(4)));
typedef unsigned v2u __attribute__((ext_vector_type(2)));
typedef float f32x4 __attribute__((ext_vector_type(4)));
typedef float f32x2 __attribute__((ext_vector_type(2)));
typedef short bf16x8 __attribute__((ext_vector_type(8)));
typedef GAS unsigned gu32;
#define RLX_AGENT __ATOMIC_RELAXED, __HIP_MEMORY_SCOPE_AGENT
#define LDS_WAIT() asm volatile("s_waitcnt lgkmcnt(0)" ::: "memory")
#define VM_WAIT() asm volatile("s_waitcnt vmcnt(0)" ::: "memory")
__device__ __forceinline__ unsigned f2bf(float f) { unsigned u = __builtin_bit_cast(unsigned, f); return (u + 0x7fffu + ((u >> 16) & 1u)) >> 16; }
__device__ __forceinline__ unsigned pk2(float lo, float hi) { return f2bf(lo) | (f2bf(hi) << 16); }
__device__ __forceinline__ float bf2f(unsigned short h) { return __builtin_bit_cast(float, (unsigned)h << 16); }
__device__ __forceinline__ float bflo(unsigned w) { return __builtin_bit_cast(float, w << 16); }
__device__ __forceinline__ float bfhi(unsigned w) { return __builtin_bit_cast(float, w & 0xffff0000u); }
__device__ __forceinline__ float sigmoidf_(float x) { return 1.0f / (1.0f + __expf(-x)); }
#define XB_TMO      128
#define XB_XCNT(j)  (256  + 64 * (j))
#define XB_XSUB(j)  (1280 + 64 * (j))
#define XB_XGEN(j)  (2304 + 64 * (j))
#define XB_TOP      3328
#define XB_TOPGEN   3392
#define XCD_BAR_WORDS 3456
#define XB_SPIN_CAP (1u << 18)

__device__ __forceinline__ unsigned xb_ld(unsigned* p)              { return __hip_atomic_load(p, __ATOMIC_RELAXED, __HIP_MEMORY_SCOPE_AGENT); }
__device__ __forceinline__ unsigned xb_add(unsigned* p, unsigned v) { return __hip_atomic_fetch_add(p, v, __ATOMIC_RELAXED, __HIP_MEMORY_SCOPE_AGENT); }
__device__ __forceinline__ unsigned xb_xcc_id() { return (unsigned)__builtin_amdgcn_s_getreg((3 << 11) | 20) & 0xFu; }
#define XB_SPIN(cond, bar) do { unsigned _sp = 0; while (cond) { __builtin_amdgcn_s_sleep(1); \
    if ((++_sp & 255u) == 0u) { if (xb_ld(&(bar)[XB_TMO])) break; if (_sp > XB_SPIN_CAP) { atomicAdd(&(bar)[XB_TMO], 1u); break; } } } } while (0)

struct XcdBarrier {
    unsigned* bar; unsigned x;
    volatile LAS unsigned* st;
};

__device__ __forceinline__ XcdBarrier xcd_barrier_post(unsigned* bar, volatile LAS unsigned* st) {
    XcdBarrier b; b.bar = bar; b.x = xb_xcc_id(); b.st = st;
    if (threadIdx.x == 0) (void)xb_add(&bar[XB_XCNT(b.x)], 1u);
    return b;
}
__device__ __forceinline__ void xcd_barrier_complete(unsigned* bar, unsigned x, unsigned& nloc, unsigned& nx) {
    const unsigned G = gridDim.x * gridDim.y * gridDim.z;
    unsigned sum, cnt, mine, sp = 0u;
    for (;;) {
        sum = 0u; cnt = 0u; mine = 0u;
#pragma unroll
        for (unsigned j = 0; j < 16; ++j) { const unsigned c = xb_ld(&bar[XB_XCNT(j)]); sum += c; cnt += (c > 0u) ? 1u : 0u; mine = (j == x) ? c : mine; }
        if (sum == G) break;
        __builtin_amdgcn_s_sleep(1);
        if ((++sp & 255u) == 0u) { if (xb_ld(&bar[XB_TMO])) break; if (sp > XB_SPIN_CAP) { atomicAdd(&bar[XB_TMO], 1u); break; } }
    }
    nloc = mine > 0u ? mine : 1u; nx = cnt > 0u ? cnt : 1u;
}

__device__ __forceinline__ void xcd_barrier(const XcdBarrier& b) {
    asm volatile("s_waitcnt vmcnt(0)" ::: "memory");
    __syncthreads();
    if (threadIdx.x == 0) {
        unsigned* bar = b.bar;
        __builtin_amdgcn_s_waitcnt(0);
        unsigned nloc = b.st[0], nx = b.st[1];
        if (nloc == 0u) { xcd_barrier_complete(bar, b.x, nloc, nx); b.st[0] = nloc; b.st[1] = nx; }
        const unsigned old = xb_add(&bar[XB_XSUB(b.x)], 1u);
        const unsigned gen = old / nloc;
        if (old + 1u == (gen + 1u) * nloc) {
            __builtin_amdgcn_fence(__ATOMIC_RELEASE, "agent");
            asm volatile("s_waitcnt vmcnt(0)" ::: "memory");
            const unsigned og = xb_add(&bar[XB_TOP], 1u);
            const unsigned tg = og / nx;
            if (og + 1u == (tg + 1u) * nx) xb_add(&bar[XB_TOPGEN], 1u);
            else XB_SPIN(xb_ld(&bar[XB_TOPGEN]) == tg, bar);
            __builtin_amdgcn_fence(__ATOMIC_ACQUIRE, "agent");
            xb_add(&bar[XB_XGEN(b.x)], 1u);
            asm volatile("s_waitcnt vmcnt(0)" ::: "memory");
        } else {
            XB_SPIN(xb_ld(&bar[XB_XGEN(b.x)]) == gen, bar);
            __builtin_amdgcn_fence(__ATOMIC_ACQUIRE, "agent");
            asm volatile("s_waitcnt vmcnt(0)" ::: "memory");
        }
    }
    __syncthreads();
}

struct Frame {
    LAS unsigned char* lds;
    volatile LAS unsigned* MISC;
    gu32* ctl;
    int tid, lane, wave;
    int vcu, G;
    const float *x, *c, *rel_bias, *norm_g, *ada_w, *ada_b, *attn_w_in, *attn_sinks, *attn_b_f, *attn_w_out, *lru_w_in, *lru_conv_w, *lru_conv_b, *lru_w_a, *lru_b_a, *lru_w_x, *lru_b_x, *lru_lambda, *lru_w_out, *final_g;
    float* out;
    float *mod, *gs, *sw1, *part, *part2, *lf, *x1;
    bf16 *W0T, *WO0T, *W1T, *WO1T, *WAT, *WXT, *R2, *QKVG, *A1, *XG;
};
__device__ __forceinline__ float wave_sum(float v) {
#pragma unroll
    for (int o = 1; o < 64; o <<= 1) v += __shfl_xor(v, o);
    return v;
}

__device__ __forceinline__ void p0_transpose_item(const float* W, int pitch, int K, int ncols, bf16* WT, LAS float* scr, int item, int lane) {
    const int nblk = ncols / 32, kb = item / nblk, nb = item % nblk, k0 = 64 * kb, n0 = 32 * nb;
#pragma unroll 8
    for (int i = 0; i < 32; ++i) { const int kk = 2 * i + (lane >> 5); scr[kk * 33 + (lane & 31)] = W[(size_t)(k0 + kk) * pitch + n0 + (lane & 31)]; }
    LDS_WAIT(); asm volatile("" ::: "memory");
    const int c = lane & 7;
#pragma unroll
    for (int j = 0; j < 4; ++j) { const int n = (lane >> 3) + 8 * j; const LAS float* s = scr + (8 * c) * 33 + n;
        v4u o; o.x = pk2(s[0 * 33], s[1 * 33]); o.y = pk2(s[2 * 33], s[3 * 33]); o.z = pk2(s[4 * 33], s[5 * 33]); o.w = pk2(s[6 * 33], s[7 * 33]);
        *(GAS v4u*)(WT + (size_t)(n0 + n) * K + k0 + 8 * c) = o; }
    LDS_WAIT(); asm volatile("" ::: "memory");
}
template <int NC> __device__ __forceinline__ void sg2(LAS float* ring, const float* in, int in_pitch, bool act, const float* W, int wp, int col0, const float* bias, float* out, int out_pitch, int tid) {
    const int b = tid & 31, kg = tid >> 5;
    float s[64];
    { const f32x4* ip = (const f32x4*)(in + (size_t)b * in_pitch + 64 * kg);
#pragma unroll
      for (int i = 0; i < 16; ++i) { const f32x4 v = ip[i]; s[4 * i] = v[0]; s[4 * i + 1] = v[1]; s[4 * i + 2] = v[2]; s[4 * i + 3] = v[3]; } }
    constexpr int C4 = NC / 4;
#pragma unroll 8
    for (int idx = tid; idx < 1024 * C4; idx += NWAVES * 64) { const int k = idx / C4, c4 = idx % C4; ((LAS f32x4*)ring)[idx] = *(const f32x4*)(W + (size_t)k * wp + col0 + 4 * c4); }
    if (act) {
#pragma unroll
        for (int i = 0; i < 64; ++i) s[i] = s[i] * sigmoidf_(s[i]); }
    __syncthreads();
    float acc[NC];
#pragma unroll
    for (int c = 0; c < NC; ++c) acc[c] = 0.f;
#pragma unroll
    for (int kk = 0; kk < 64; ++kk) { const LAS f32x4* wl = (const LAS f32x4*)(ring + (64 * kg + kk) * NC); const float sv = s[kk];
#pragma unroll
        for (int q = 0; q < C4; ++q) { const f32x4 w = wl[q]; acc[4 * q] += sv * w[0]; acc[4 * q + 1] += sv * w[1]; acc[4 * q + 2] += sv * w[2]; acc[4 * q + 3] += sv * w[3]; } }
    __syncthreads();
#pragma unroll
    for (int c = 0; c < NC; ++c) ring[(kg * 32 + b) * NC + c] = acc[c];
    __syncthreads();
    for (int o = tid; o < 32 * NC; o += NWAVES * 64) { const int bb = o / NC, c = o % NC; float t = bias ? bias[col0 + c] : 0.f;
#pragma unroll
        for (int g = 0; g < 16; ++g) t += ring[(g * 32 + bb) * NC + c];
        out[(size_t)bb * out_pitch + col0 + c] = t; }
    __syncthreads();
}

__device__ __forceinline__ void p0a(Frame& F) {
    LAS float* ring = (LAS float*)(F.lds + RING_OFF);
    for (int it = F.vcu; it < 192; it += F.G) {
        const int l = it / 96, cb = it % 96;
        sg2<32>(ring, F.c, D, true, F.ada_w + (size_t)l * D * 3072, 3072, cb * 32, F.ada_b + l * 3072, F.mod + (size_t)l * 32 * 3072, 3072, F.tid);
    }
    LAS float* scr = (LAS float*)(F.lds + RING_OFF + F.wave * 16384);
    const int gw = F.vcu * NWAVES + F.wave, NGW = F.G * NWAVES;
    constexpr int I_W0A = (D / 64) * (2304 / 32), I_W0B = (D / 64) * (1024 / 32), I_SQ = (D / 64) * (D / 32), I_W1 = (D / 64) * (2048 / 32), I_G = (128 / 64) * (128 / 32);
    constexpr int NITEMS = I_W0A + I_W0B + I_SQ + I_W1 + I_SQ + 16 * I_G;
    for (int it = gw; it < NITEMS; it += NGW) {
        int r = it;
        if (r < I_W0A) { p0_transpose_item(F.attn_w_in, ATTN_IN, D, 2304, F.W0T, scr, r, F.lane); continue; } r -= I_W0A;
        if (r < I_W0B) { p0_transpose_item(F.attn_w_in + 2312, ATTN_IN, D, 1024, F.W0T + (size_t)2304 * D, scr, r, F.lane); continue; } r -= I_W0B;
        if (r < I_SQ) { p0_transpose_item(F.attn_w_out, D, D, D, F.WO0T, scr, r, F.lane); continue; } r -= I_SQ;
        if (r < I_W1) { p0_transpose_item(F.lru_w_in, 2048, D, 2048, F.W1T, scr, r, F.lane); continue; } r -= I_W1;
        if (r < I_SQ) { p0_transpose_item(F.lru_w_out, D, D, D, F.WO1T, scr, r, F.lane); continue; } r -= I_SQ;
        { const int mtx = r / I_G, item = r % I_G; const int n = mtx & 7;
          if (mtx < 8) p0_transpose_item(F.lru_w_a + (size_t)n * 16384, 128, 128, 128, F.WAT + (size_t)n * 16384, scr, item, F.lane);
          else         p0_transpose_item(F.lru_w_x + (size_t)n * 16384, 128, 128, 128, F.WXT + (size_t)n * 16384, scr, item, F.lane); }
    }
}

__device__ __forceinline__ void p0b(Frame& F) {
    LAS float* ring = (LAS float*)(F.lds + RING_OFF);
    for (int idx = F.vcu * 512 + F.tid; idx < 2 * 32 * 1024; idx += F.G * 512) { const int k = idx & 1023, lb = idx >> 10, l = lb >> 5;
        F.gs[idx] = F.norm_g[l * 1024 + k] * (1.0f + F.mod[(size_t)lb * 3072 + 1024 + k]); }
    for (int it = F.vcu; it < 256; it += F.G)
        sg2<8>(ring, F.mod + (size_t)32 * 3072, 3072, false, F.lru_w_in, 2048, it * 8, nullptr, F.sw1, 2048, F.tid);
    __syncthreads();
    { LAS f32x4* wft = (LAS f32x4*)ring;
      for (int idx = F.tid; idx < 32 * 64; idx += NWAVES * 64) { const int pc = idx >> 6, l = idx & 63, half = pc & 1, je = pc >> 1, j = je >> 2, e = je & 3, k = 4 * l + 256 * j + e;
          wft[idx] = *(const f32x4*)(F.attn_w_in + (size_t)k * ATTN_IN + 2304 + 4 * half); } }
    __syncthreads();
    const LAS f32x4* wfl = (const LAS f32x4*)ring + F.lane;
    const int gw = F.vcu * NWAVES + F.wave, NGW = F.G * NWAVES;
    for (int ch = gw; ch < M / 32; ch += NGW) {
        const int b = ch >> 6;
        f32x4 gsv[4], shv[4];
#pragma unroll
        for (int j = 0; j < 4; ++j) { const int k = 4 * F.lane + 256 * j;
            const f32x4 g = *(const f32x4*)(F.norm_g + k), sc = *(const f32x4*)(F.mod + (size_t)b * 3072 + 1024 + k);
            gsv[j] = g * (1.0f + sc); shv[j] = *(const f32x4*)(F.mod + (size_t)b * 3072 + k); }
        const float bf_mine = F.attn_b_f[F.lane >> 3];
        const GAS f32x4* xr0 = (const GAS f32x4*)(F.x + (size_t)ch * 32 * D) + F.lane;
        f32x4 vn[4];
#pragma unroll
        for (int j = 0; j < 4; ++j) vn[j] = xr0[64 * j];
        for (int r = 0; r < 32; ++r) {
            const int m = ch * 32 + r;
            f32x4 v[4]; float ss = 0.f;
#pragma unroll
            for (int j = 0; j < 4; ++j) { v[j] = vn[j]; ss += (v[j][0] * v[j][0] + v[j][1] * v[j][1]) + (v[j][2] * v[j][2] + v[j][3] * v[j][3]); }
            if (r + 1 < 32) {
#pragma unroll
                for (int j = 0; j < 4; ++j) vn[j] = xr0[(size_t)(r + 1) * (D / 4) + 64 * j]; }
            const float rstd = 1.0f / sqrtf(wave_sum(ss) * (1.0f / D) + EPS);
            float p[8];
#pragma unroll
            for (int q = 0; q < 8; ++q) p[q] = 0.f;
            GAS unsigned long long* o8 = (GAS unsigned long long*)(F.R2 + (size_t)m * D) + F.lane;
#pragma unroll
            for (int j = 0; j < 4; ++j) { const f32x4 h = v[j] * rstd * gsv[j] + shv[j];
                o8[64 * j] = (unsigned long long)pk2(h[0], h[1]) | ((unsigned long long)pk2(h[2], h[3]) << 32);
#pragma unroll
                for (int e = 0; e < 4; ++e) { const f32x4 w0 = wfl[((j * 4 + e) * 2) * 64], w1 = wfl[((j * 4 + e) * 2 + 1) * 64];
#pragma unroll
                    for (int q = 0; q < 4; ++q) { p[q] += h[e] * w0[q]; p[4 + q] += h[e] * w1[q]; } } }
            const bool u5 = (F.lane & 32) != 0, u4 = (F.lane & 16) != 0, u3 = (F.lane & 8) != 0;
            float s4[4], s2[2], s1;
#pragma unroll
            for (int i = 0; i < 4; ++i) { const float snd = u5 ? p[i] : p[4 + i], kp = u5 ? p[4 + i] : p[i]; s4[i] = kp + __shfl_xor(snd, 32); }
#pragma unroll
            for (int i = 0; i < 2; ++i) { const float snd = u4 ? s4[i] : s4[2 + i], kp = u4 ? s4[2 + i] : s4[i]; s2[i] = kp + __shfl_xor(snd, 16); }
            { const float snd = u3 ? s2[0] : s2[1], kp = u3 ? s2[1] : s2[0]; s1 = kp + __shfl_xor(snd, 8); }
            s1 += __shfl_xor(s1, 4); s1 += __shfl_xor(s1, 2); s1 += __shfl_xor(s1, 1);
            const float z = s1 + bf_mine;
            const float lfv = fminf(z, 0.f) - __logf(1.0f + __expf(-fabsf(z)));
            if ((F.lane & 7) == 0) F.lf[(size_t)m * 8 + (F.lane >> 3)] = lfv;
        }
    }
}

__device__ __forceinline__ void p7(Frame& F) {
    const int gw = F.vcu * NWAVES + F.wave, NGW = F.G * NWAVES;
    f32x4 g[4];
#pragma unroll
    for (int j = 0; j < 4; ++j) g[j] = *(const f32x4*)(F.final_g + 4 * F.lane + 256 * j);
    for (int m = gw; m < M; m += NGW) {
        const float pv = F.part2[(size_t)m * 16 + (F.lane & 15)];
        float s = pv; s += __shfl_xor(s, 1); s += __shfl_xor(s, 2); s += __shfl_xor(s, 4); s += __shfl_xor(s, 8);
        const float rstd = 1.0f / sqrtf(s * (1.0f / D) + EPS);
        GAS f32x4* o = (GAS f32x4*)(F.out + (size_t)m * D) + F.lane;
#pragma unroll
        for (int j = 0; j < 4; ++j) { f32x4 v = o[64 * j]; v = v * rstd * g[j];
#if PHASE_TIMING
            v = v + sqrtf((float)(F.ctl[1100 + PT_A + 1] - F.ctl[1100 + PT_A]) * 1e-9f); if (m == 0 && j == 0 && F.lane == 0) v[0] += (float)(F.ctl[1100 + PT_B + 1] - F.ctl[1100 + PT_B]) * 1e-5f;
#endif
            o[64 * j] = v; }
    }
}

__device__ __forceinline__ int t5_bucket(int rel) {
    if (rel < 16) return rel;
    const float v = logf((float)rel / 16.0f) / logf(8.0f) * 16.0f;
    int l = 16 + (int)v; return l < 31 ? l : 31;
}
__device__ __forceinline__ void block_cumsum_2048(const float* src, int stride, LAS float* sF, LAS float* sTmp, int tid, int lane, int wave) {
    float v0 = src[(size_t)(4 * tid + 0) * stride], v1 = src[(size_t)(4 * tid + 1) * stride], v2 = src[(size_t)(4 * tid + 2) * stride], v3 = src[(size_t)(4 * tid + 3) * stride];
    v1 += v0; v2 += v1; v3 += v2;
    float s = v3;
#pragma unroll
    for (int o = 1; o < 64; o <<= 1) { const float t = __shfl_up(s, o); if (lane >= o) s += t; }
    if (lane == 63) sTmp[wave] = s;
    __syncthreads();
    float base = s - v3;
    for (int w = 0; w < wave; ++w) base += sTmp[w];
    sF[4 * tid + 0] = base + v0; sF[4 * tid + 1] = base + v1; sF[4 * tid + 2] = base + v2; sF[4 * tid + 3] = base + v3;
    __syncthreads();
}
__device__ __forceinline__ void p2_naive(Frame& F) {
    LAS float* sF = (LAS float*)(F.lds + RING_OFF);
    LAS float* sTmp = sF + 2048;
    LAS float* sB = sF + 2048 + 64;
    const int tid = F.tid;
    for (int bh = F.vcu; bh < BATCH * BH; bh += F.G) {
        const int b = bh >> 3, h = bh & 7;
        block_cumsum_2048(F.lf + (size_t)b * SEQ * 8 + h, 8, sF, sTmp, tid, F.lane, F.wave);
        for (int it = 0; it < 4; ++it) {
            const int t = it * 512 + tid; const size_t m = (size_t)b * SEQ + t;
            float q[64], o[64];
            const bf16* qp = F.QKVG + m * NQ + C_BQ + 64 * h;
#pragma unroll
            for (int d = 0; d < 64; ++d) { q[d] = bf2f(qp[d]); o[d] = 0.f; }
            const float Ft = sF[t] * LOG2E;
            float mx = -INFINITY, l = 0.f;
            const int tmax = it * 512 + (tid | 63);
            for (int s = 0; s <= tmax; ++s) {
                const bf16* kp = F.QKVG + ((size_t)b * SEQ + s) * NQ + C_BK + 64 * h; const bf16* vp = kp + (C_BV - C_BK);
                float dot = 0.f;
#pragma unroll
                for (int d8 = 0; d8 < 8; ++d8) { const v4u kk = *(const v4u*)(kp + 8 * d8);
                    dot += q[8 * d8 + 0] * bflo(kk.x) + q[8 * d8 + 1] * bfhi(kk.x) + q[8 * d8 + 2] * bflo(kk.y) + q[8 * d8 + 3] * bfhi(kk.y)
                         + q[8 * d8 + 4] * bflo(kk.z) + q[8 * d8 + 5] * bfhi(kk.z) + q[8 * d8 + 6] * bflo(kk.w) + q[8 * d8 + 7] * bfhi(kk.w); }
                const float logit = dot + Ft - sF[s] * LOG2E;
                if (s <= t) {
                    if (logit > mx) { const float f = exp2f(mx - logit); l *= f;
#pragma unroll
                        for (int d = 0; d < 64; ++d) o[d] *= f;
                        mx = logit; }
                    const float p = exp2f(logit - mx); l += p;
#pragma unroll
                    for (int d8 = 0; d8 < 8; ++d8) { const v4u vv = *(const v4u*)(vp + 8 * d8);
                        o[8 * d8 + 0] += p * bflo(vv.x); o[8 * d8 + 1] += p * bfhi(vv.x); o[8 * d8 + 2] += p * bflo(vv.y); o[8 * d8 + 3] += p * bfhi(vv.y);
                        o[8 * d8 + 4] += p * bflo(vv.z); o[8 * d8 + 5] += p * bfhi(vv.z); o[8 * d8 + 6] += p * bflo(vv.w); o[8 * d8 + 7] += p * bfhi(vv.w); }
                }
            }
            const float rl = 1.0f / l;
            const bf16* gp = F.QKVG + m * NQ + C_G + 512 + 64 * h; bf16* yp = F.R2 + m * D + 512 + 64 * h;
#pragma unroll
            for (int d = 0; d < 64; ++d) { const float g = bf2f(gp[d]); yp[d] = (bf16)f2bf(o[d] * rl * g * sigmoidf_(g)); }
        }
        __syncthreads();
    }
    for (int it0 = F.vcu; it0 < BATCH * AKVH * 4; it0 += F.G) {
        const int pair = it0 >> 2, b = pair >> 1, kvh = pair & 1, t0 = (it0 & 3) * 512;
        __syncthreads();
        { const int g = tid >> 7, rel = tid & 127; sB[tid] = F.rel_bias[t5_bucket(rel) * AQH + kvh * 4 + g] * LOG2E; }
        __syncthreads();
        for (int g = 0; g < 4; ++g) {
            const int hq = kvh * 4 + g, t = t0 + tid; const size_t m = (size_t)b * SEQ + t;
            float q[64], o[64];
            const bf16* qp = F.QKVG + m * NQ + C_AQ + 64 * hq;
#pragma unroll
            for (int d = 0; d < 64; ++d) { q[d] = bf2f(qp[d]); o[d] = 0.f; }
            float mx = F.attn_sinks[hq] * LOG2E, l = 1.0f;
            for (int rel = 0; rel < WINDOW; ++rel) {
                const int s = t - rel;
                if (s >= 0) {
                    const bf16* kp = F.QKVG + ((size_t)b * SEQ + s) * NQ + C_AK + 64 * kvh; const bf16* vp = kp + (C_AV - C_AK);
                    float dot = 0.f;
#pragma unroll
                    for (int d8 = 0; d8 < 8; ++d8) { const v4u kk = *(const v4u*)(kp + 8 * d8);
                        dot += q[8 * d8 + 0] * bflo(kk.x) + q[8 * d8 + 1] * bfhi(kk.x) + q[8 * d8 + 2] * bflo(kk.y) + q[8 * d8 + 3] * bfhi(kk.y)
                             + q[8 * d8 + 4] * bflo(kk.z) + q[8 * d8 + 5] * bfhi(kk.z) + q[8 * d8 + 6] * bflo(kk.w) + q[8 * d8 + 7] * bfhi(kk.w); }
                    const float logit = dot + sB[g * 128 + rel];
                    if (logit > mx) { const float f = exp2f(mx - logit); l *= f;
#pragma unroll
                        for (int d = 0; d < 64; ++d) o[d] *= f;
                        mx = logit; }
                    const float p = exp2f(logit - mx); l += p;
#pragma unroll
                    for (int d8 = 0; d8 < 8; ++d8) { const v4u vv = *(const v4u*)(vp + 8 * d8);
                        o[8 * d8 + 0] += p * bflo(vv.x); o[8 * d8 + 1] += p * bfhi(vv.x); o[8 * d8 + 2] += p * bflo(vv.y); o[8 * d8 + 3] += p * bfhi(vv.y);
                        o[8 * d8 + 4] += p * bflo(vv.z); o[8 * d8 + 5] += p * bfhi(vv.z); o[8 * d8 + 6] += p * bflo(vv.w); o[8 * d8 + 7] += p * bfhi(vv.w); }
                }
            }
            const float rl = 1.0f / l;
            const bf16* gp = F.QKVG + m * NQ + C_G + 64 * hq; bf16* yp = F.R2 + m * D + 64 * hq;
#pragma unroll
            for (int d = 0; d < 64; ++d) { const float gg = bf2f(gp[d]); yp[d] = (bf16)f2bf(o[d] * rl * gg * sigmoidf_(gg)); }
        }
    }
    __syncthreads();
}
__device__ __forceinline__ void p5_naive(Frame& F) {
    LAS float* sXc = (LAS float*)(F.lds + RING_OFF);
    const int tid = F.tid, cl = tid >> 2, part = tid & 3;
    for (int item = F.vcu; item < BATCH * 8; item += F.G) {
        const int b = item >> 3, n = item & 7, c = n * 128 + cl;
        const float w0 = F.lru_conv_w[c], w1 = F.lru_conv_w[1024 + c], w2 = F.lru_conv_w[2048 + c], w3 = F.lru_conv_w[3072 + c], cb = F.lru_conv_b[c];
        const float ba = F.lru_b_a[c], bx = F.lru_b_x[c];
        const float lam = F.lru_lambda[c], sp = fmaxf(-lam, 0.f) + log1pf(expf(-fabsf(lam)));
        const bf16* wa = F.WAT + (size_t)n * 16384 + (size_t)cl * 128 + 32 * part; const bf16* wx = F.WXT + (size_t)n * 16384 + (size_t)cl * 128 + 32 * part;
        float wav[32], wxv[32];
#pragma unroll
        for (int i = 0; i < 32; ++i) { wav[i] = bf2f(wa[i]); wxv[i] = bf2f(wx[i]); }
        float xm1 = 0.f, xm2 = 0.f, xm3 = 0.f, hst = 0.f;
        __syncthreads();
        for (int t = 0; t < SEQ; ++t) {
            const size_t m = (size_t)b * SEQ + t;
            const float x0 = bf2f(F.XG[m * NXG + c]);
            const float xc = cb + w0 * xm3 + w1 * xm2 + w2 * xm1 + w3 * x0;
            xm3 = xm2; xm2 = xm1; xm1 = x0;
            LAS float* sx = sXc + (t & 1) * 128;
            if (part == 0) sx[cl] = xc;
            __syncthreads();
            float ra = 0.f, ia = 0.f;
#pragma unroll
            for (int i = 0; i < 32; ++i) { const float xv = sx[32 * part + i]; ra += xv * wav[i]; ia += xv * wxv[i]; }
            ra += __shfl_xor(ra, 1); ra += __shfl_xor(ra, 2); ia += __shfl_xor(ia, 1); ia += __shfl_xor(ia, 2);
            const float r = sigmoidf_(ra + ba), ig = sigmoidf_(ia + bx);
            const float log_a = -8.0f * r * sp, a = expf(log_a), mult = sqrtf(-expm1f(2.0f * log_a));
            hst = a * hst + mult * (ig * xc);
            if (part == 0) { const float g = bf2f(F.XG[m * NXG + 1024 + c]); F.R2[m * D + c] = (bf16)f2bf(hst * g * sigmoidf_(g)); }
        }
        __syncthreads();
    }
}

template <int EPI> __device__ __forceinline__ void naive_gemm(Frame& F, const bf16* A, const bf16* Bt, int N) {
    const int gw = F.vcu * NWAVES + F.wave, NGW = F.G * NWAVES, nch = N / 64;
    for (long it = gw; it < (long)M * nch; it += NGW) {
        const int m = (int)(it / nch), ch = (int)(it % nch), n = ch * 64 + F.lane, b = m / SEQ;
        const bf16* ap = A + (size_t)m * D; const bf16* bp = Bt + (size_t)n * D;
        float acc = 0.f;
        for (int k = 0; k < D; k += 8) { const v4u a = *(const v4u*)(ap + k), w = *(const v4u*)(bp + k);
            acc += bflo(a.x) * bflo(w.x) + bfhi(a.x) * bfhi(w.x) + bflo(a.y) * bflo(w.y) + bfhi(a.y) * bfhi(w.y) + bflo(a.z) * bflo(w.z) + bfhi(a.z) * bfhi(w.z) + bflo(a.w) * bflo(w.w) + bfhi(a.w) * bfhi(w.w); }
        if (EPI == 0) { const int pn = n >> 8; const float s = (pn == 0 || pn == 1 || pn == 3 || pn == 4) ? QSCALE : 1.f; F.QKVG[(size_t)m * NQ + n] = (bf16)f2bf(acc * s); }
        if (EPI == 1) { const float x1 = F.x[(size_t)m * D + n] + F.mod[(size_t)b * 3072 + 2048 + n] * acc; F.x1[(size_t)m * D + n] = x1;
            F.A1[(size_t)m * D + n] = (bf16)f2bf(x1 * F.gs[32 * 1024 + b * 1024 + n]); const float ss = wave_sum(x1 * x1); if (F.lane == 0) F.part[(size_t)m * 16 + ch] = ss; }
        if (EPI == 2) { float ps = F.part[(size_t)m * 16 + (F.lane & 15)]; ps += __shfl_xor(ps, 1); ps += __shfl_xor(ps, 2); ps += __shfl_xor(ps, 4); ps += __shfl_xor(ps, 8);
            const float rstd = 1.0f / sqrtf(ps * (1.0f / D) + EPS); F.XG[(size_t)m * NXG + n] = (bf16)f2bf(acc * rstd + F.sw1[(size_t)b * 2048 + n]); }
        if (EPI == 3) { const float x2 = F.x1[(size_t)m * D + n] + F.mod[(size_t)(32 + b) * 3072 + 2048 + n] * acc; F.out[(size_t)m * D + n] = x2;
            const float ss = wave_sum(x2 * x2); if (F.lane == 0) F.part2[(size_t)m * 16 + ch] = ss; }
    }
}

__device__ __forceinline__ float fast_sigmoid(float z) { return __builtin_amdgcn_rcpf(1.0f + __builtin_amdgcn_exp2f(-LOG2E * z)); }
__device__ __forceinline__ void p5_lru(Frame& F) {
    constexpr int XCP = 136, AUP = 132;
    constexpr int OFF_XC = 0, OFF_G = 17408, OFF_A = OFF_G + 2 * 16384, OFF_U = OFF_A + 64 * AUP * 4, OFF_COMB = OFF_U + 64 * AUP * 4, OFF_ST = OFF_COMB + 8192;
    static_assert(OFF_ST + 1024 <= RING_BYTES, "P5 LDS map");
    LAS unsigned char* L = F.lds + RING_OFF;
    LAS bf16* sXC = (LAS bf16*)(L + OFF_XC);
    LAS float* sA = (LAS float*)(L + OFF_A); LAS float* sU = (LAS float*)(L + OFF_U);
    LAS f32x4* sComb = (LAS f32x4*)(L + OFF_COMB); LAS float* sSt = (LAS float*)(L + OFF_ST);
    const int tid = F.tid, lane = F.lane, wave = F.wave;
    const int t2 = tid >> 4, c8 = tid & 15;
    const int v2 = 16 * wave + (lane & 15), q2 = lane >> 4;
    for (int item = F.vcu; item < BATCH * 8; item += F.G) {
        const int b = item >> 3, n = item & 7;
        float cw[4][8], cbv[8];
        { const int c0 = n * 128 + 8 * c8;
#pragma unroll
          for (int j = 0; j < 4; ++j) { const f32x4 lo = *(const f32x4*)(F.lru_conv_w + j * 1024 + c0), hi = *(const f32x4*)(F.lru_conv_w + j * 1024 + c0 + 4);
              cw[j][0] = lo[0]; cw[j][1] = lo[1]; cw[j][2] = lo[2]; cw[j][3] = lo[3]; cw[j][4] = hi[0]; cw[j][5] = hi[1]; cw[j][6] = hi[2]; cw[j][7] = hi[3]; }
          const f32x4 lo = *(const f32x4*)(F.lru_conv_b + c0), hi = *(const f32x4*)(F.lru_conv_b + c0 + 4);
          cbv[0] = lo[0]; cbv[1] = lo[1]; cbv[2] = lo[2]; cbv[3] = lo[3]; cbv[4] = hi[0]; cbv[5] = hi[1]; cbv[6] = hi[2]; cbv[7] = hi[3]; }
        const int cg2 = n * 128 + v2;
        const float ba2 = F.lru_b_a[cg2], bx2 = F.lru_b_x[cg2];
        float nsp8; { const float lam = F.lru_lambda[cg2]; nsp8 = -8.0f * (fmaxf(-lam, 0.f) + log1pf(expf(-fabsf(lam)))); }
        bf16x8 Br[4], Bi[4];
#pragma unroll
        for (int ks = 0; ks < 4; ++ks) { Br[ks] = *(const bf16x8*)(F.WAT + (size_t)n * 16384 + (size_t)v2 * 128 + 32 * ks + 8 * q2); Bi[ks] = *(const bf16x8*)(F.WXT + (size_t)n * 16384 + (size_t)v2 * 128 + 32 * ks + 8 * q2); }
        if (tid < 128) sSt[tid] = 0.f;
        const bf16* xbase = F.XG + (size_t)b * SEQ * NXG + n * 128 + 8 * c8;
        bf16* ybase = F.R2 + (size_t)b * SEQ * D + n * 128 + 2 * lane;
        v4u xrw[5], gv[2];
#pragma unroll
        for (int r = 0; r < 5; ++r) { const int tt = 2 * t2 - 3 + r; xrw[r] = (tt >= 0) ? *(const v4u*)(xbase + (size_t)tt * NXG) : (v4u){0u, 0u, 0u, 0u}; }
        gv[0] = *(const v4u*)(xbase + (size_t)(2 * t2) * NXG + 1024); gv[1] = *(const v4u*)(xbase + (size_t)(2 * t2 + 1) * NXG + 1024);
        __syncthreads();
        for (int ch = 0; ch < SEQ / 64; ++ch) {
            const int par = ch & 1, tb = ch * 64;
            LAS bf16* sG = (LAS bf16*)(L + OFF_G + par * 16384);
            {
                float xf[5][8];
#pragma unroll
                for (int r = 0; r < 5; ++r) { xf[r][0] = bflo(xrw[r].x); xf[r][1] = bfhi(xrw[r].x); xf[r][2] = bflo(xrw[r].y); xf[r][3] = bfhi(xrw[r].y); xf[r][4] = bflo(xrw[r].z); xf[r][5] = bfhi(xrw[r].z); xf[r][6] = bflo(xrw[r].w); xf[r][7] = bfhi(xrw[r].w); }
#pragma unroll
                for (int e = 0; e < 2; ++e) { float xc[8];
#pragma unroll
                    for (int j = 0; j < 8; ++j) xc[j] = cbv[j] + cw[0][j] * xf[e][j] + cw[1][j] * xf[e + 1][j] + cw[2][j] * xf[e + 2][j] + cw[3][j] * xf[e + 3][j];
                    v4u o; o.x = pk2(xc[0], xc[1]); o.y = pk2(xc[2], xc[3]); o.z = pk2(xc[4], xc[5]); o.w = pk2(xc[6], xc[7]);
                    *(LAS v4u*)(sXC + (2 * t2 + e) * XCP + 8 * c8) = o;
                    *(LAS v4u*)(sG + (2 * t2 + e) * 128 + 8 * c8) = gv[e]; }
            }
            __syncthreads();
            if (ch + 1 < SEQ / 64) {
#pragma unroll
                for (int r = 0; r < 5; ++r) xrw[r] = *(const v4u*)(xbase + (size_t)(tb + 64 + 2 * t2 - 3 + r) * NXG);
                gv[0] = *(const v4u*)(xbase + (size_t)(tb + 64 + 2 * t2) * NXG + 1024); gv[1] = *(const v4u*)(xbase + (size_t)(tb + 64 + 2 * t2 + 1) * NXG + 1024);
            }
#pragma unroll
            for (int jt = 0; jt < 4; ++jt) {
                f32x4 ar = {0.f, 0.f, 0.f, 0.f}, ai = {0.f, 0.f, 0.f, 0.f};
#pragma unroll
                for (int ks = 0; ks < 4; ++ks) { const bf16x8 af = *(const LAS bf16x8*)(sXC + (16 * jt + (lane & 15)) * XCP + 32 * ks + 8 * q2);
                    ar = __builtin_amdgcn_mfma_f32_16x16x32_bf16(af, Br[ks], ar, 0, 0, 0); ai = __builtin_amdgcn_mfma_f32_16x16x32_bf16(af, Bi[ks], ai, 0, 0, 0); }
#pragma unroll
                for (int r = 0; r < 4; ++r) { const int t = 16 * jt + 4 * q2 + r;
                    const float rg = fast_sigmoid(ar[r] + ba2), ig = fast_sigmoid(ai[r] + bx2);
                    const float la = rg * nsp8, a = __builtin_amdgcn_exp2f(LOG2E * la);
                    const float y = 2.0f * la;
                    const float om = -y * (1.0f + y * (0.5f + y * (0.16666667f + y * (0.041666668f + y * (0.0083333338f + y * 0.0013888889f)))));
                    const float xcv = bf2f(sXC[t * XCP + v2]);
                    sA[t * AUP + v2] = a; sU[t * AUP + v2] = __builtin_amdgcn_sqrtf(om) * (ig * xcv); }
            }
            __syncthreads();
            float P0[8], P1[8], h0[8], h1[8];
            { float p0 = 1.f, p1 = 1.f, g0 = 0.f, g1 = 0.f;
#pragma unroll
              for (int i = 0; i < 8; ++i) { const int t = 8 * wave + i; const f32x2 av = *(const LAS f32x2*)(sA + t * AUP + 2 * lane), uv = *(const LAS f32x2*)(sU + t * AUP + 2 * lane);
                  p0 *= av.x; p1 *= av.y; g0 = av.x * g0 + uv.x; g1 = av.y * g1 + uv.y; P0[i] = p0; P1[i] = p1; h0[i] = g0; h1[i] = g1; }
              sComb[wave * 64 + lane] = (f32x4){p0, p1, g0, g1}; }
            __syncthreads();
            { const f32x2 cs = *(const LAS f32x2*)(sSt + par * 128 + 2 * lane); float c0 = cs.x, c1 = cs.y;
              for (int w = 0; w < wave; ++w) { const f32x4 cm = sComb[w * 64 + lane]; c0 = cm[0] * c0 + cm[2]; c1 = cm[1] * c1 + cm[3]; }
#pragma unroll
              for (int i = 0; i < 8; ++i) { const int t = 8 * wave + i;
                  const float hh0 = h0[i] + P0[i] * c0, hh1 = h1[i] + P1[i] * c1;
                  const unsigned gw = *(const LAS unsigned*)(sG + t * 128 + 2 * lane); const float g0 = bflo(gw), g1 = bfhi(gw);
                  *(unsigned*)(ybase + (size_t)(tb + t) * D) = pk2(hh0 * g0 * fast_sigmoid(g0), hh1 * g1 * fast_sigmoid(g1));
                  if (i == 7 && wave == 7) *(LAS f32x2*)(sSt + (par ^ 1) * 128 + 2 * lane) = (f32x2){hh0, hh1}; }
            }
        }
        __syncthreads();
    }
}

typedef float f32x16 __attribute__((ext_vector_type(16)));
typedef short s16x4 __attribute__((ext_vector_type(4)));
typedef short v4i16_t __attribute__((ext_vector_type(4)));
constexpr int A_K = 0, A_V = 32768, A_STG = 65536, A_WSF = 98304, A_F = 100352, A_END = A_F + 8192;
static_assert(A_END <= RING_BYTES, "P2 LDS map");
__device__ __forceinline__ int crow(int r, int hi) { return (r & 3) + 8 * (r >> 2) + 4 * hi; }
__device__ __forceinline__ unsigned cvtpk(float lo, float hi) { typedef float f2 __attribute__((ext_vector_type(2))); typedef __bf16 b2 __attribute__((ext_vector_type(2))); f2 v = {lo, hi}; b2 b = __builtin_convertvector(v, b2); return __builtin_bit_cast(unsigned, b); }
__device__ __forceinline__ s16x4 vtr(const LAS unsigned char* p) { return __builtin_bit_cast(s16x4, __builtin_amdgcn_ds_read_tr16_b64_v4i16((LAS v4i16_t*)p)); }
__device__ __forceinline__ float half_max(float v) { auto rr = __builtin_amdgcn_permlane32_swap(__float_as_uint(v), __float_as_uint(v), false, false); return fmaxf(__uint_as_float(rr[0]), __uint_as_float(rr[1])); }
__device__ __forceinline__ float half_sum(float v) { auto rr = __builtin_amdgcn_permlane32_swap(__float_as_uint(v), __float_as_uint(v), false, false); return __uint_as_float(rr[0]) + __uint_as_float(rr[1]); }
#define MFMA32(a, b, c) __builtin_amdgcn_mfma_f32_32x32x16_bf16(a, b, c, 0, 0, 0)
__device__ __forceinline__ void dma16(const void* gsrc, LAS unsigned char* lds_wave_base) { __builtin_amdgcn_global_load_lds((const unsigned*)gsrc, (LAS unsigned*)lds_wave_base, 16, 0, 0); }
__device__ __forceinline__ void dma_kv_tile(const bf16* krow0, const bf16* vrow0, LAS unsigned char* kslot, LAS unsigned char* vslot, int wave, int lane) {
    dma16(krow0 + (size_t)lane * NQ + wave * 8, kslot + wave * 1024);
    dma16(vrow0 + (size_t)(16 * (wave & 3) + (lane >> 2)) * NQ + (wave >> 2) * 32 + (lane & 3) * 8, vslot + wave * 1024);
}
__device__ __forceinline__ void qkt(f32x16& x0, f32x16& x1, const LAS unsigned char* kslot, const bf16x8 (&qr)[4], int r32, int hi) {
    const LAS unsigned char* kb = kslot + hi * 1024 + r32 * 16;
#pragma unroll
    for (int d0 = 0; d0 < 4; ++d0) { const bf16x8 b0 = *(const LAS bf16x8*)(kb + d0 * 2048), b1 = *(const LAS bf16x8*)(kb + d0 * 2048 + 512);
        x0 = MFMA32(b0, qr[d0], x0); x1 = MFMA32(b1, qr[d0], x1); }
}
template <bool FIRST> __device__ __forceinline__ void softmax_pv(f32x16 (&o)[2], float& m, float& l, f32x16& x0, f32x16& x1, const LAS unsigned char* vslot, LAS float* wsf, int lane, int r32, int hi) {
    float a = fmaxf(x0[0], x1[0]);
#pragma unroll
    for (int r = 1; r < 16; ++r) a = fmaxf(a, fmaxf(x0[r], x1[r]));
    const float rm = half_max(a);
    if (FIRST) {
        m += rm;
#pragma unroll
        for (int r = 0; r < 16; ++r) { x0[r] -= rm; x1[r] -= rm; }
    } else if (__any(rm > 0.f)) {
        const float dl = fmaxf(rm, 0.f); m += dl;
#pragma unroll
        for (int r = 0; r < 16; ++r) { x0[r] -= dl; x1[r] -= dl; }
        const float f = __builtin_amdgcn_exp2f(-dl); l *= f;
        if (hi == 0) wsf[r32] = f;
        asm volatile("s_waitcnt lgkmcnt(0)" ::: "memory");
#pragma unroll
        for (int r = 0; r < 16; ++r) { const float fr = wsf[crow(r, hi)]; o[0][r] *= fr; o[1][r] *= fr; }
        asm volatile("s_waitcnt lgkmcnt(0)" ::: "memory");
    }
    float sacc = 0.f;
#pragma unroll
    for (int r = 0; r < 16; ++r) { x0[r] = __builtin_amdgcn_exp2f(x0[r]); x1[r] = __builtin_amdgcn_exp2f(x1[r]); sacc += x0[r] + x1[r]; }
    l += sacc;
    typedef unsigned u32x4_t __attribute__((ext_vector_type(4)));
    u32x4_t pw[4];
#pragma unroll
    for (int k = 0; k < 2; ++k)
#pragma unroll
        for (int e = 0; e < 4; ++e) { pw[k][e] = cvtpk(x0[8 * k + 2 * e], x0[8 * k + 2 * e + 1]); pw[2 + k][e] = cvtpk(x1[8 * k + 2 * e], x1[8 * k + 2 * e + 1]); }
    const LAS unsigned char* vp = vslot + ((lane >> 4) & 1) * 32 + (lane & 3) * 8 + (4 * hi + ((lane & 15) >> 2)) * 64;
#pragma unroll
    for (int dh = 0; dh < 2; ++dh)
#pragma unroll
        for (int ks = 0; ks < 4; ++ks) { const s16x4 lo = vtr(vp + dh * 4096 + ks * 1024), hh = vtr(vp + dh * 4096 + ks * 1024 + 512);
            const bf16x8 vf = {lo[0], lo[1], lo[2], lo[3], hh[0], hh[1], hh[2], hh[3]};
            o[dh] = MFMA32(__builtin_bit_cast(bf16x8, pw[ks]), vf, o[dh]); }
}
__device__ __forceinline__ void attn_epilogue(f32x16 (&o)[2], float l_part, LAS float* wsf, LAS float* stg, const bf16* gate_rows, bf16* y_rows, int lane, int r32, int hi) {
    v4u gq[2][2];
#pragma unroll
    for (int dh = 0; dh < 2; ++dh)
#pragma unroll
        for (int it = 0; it < 2; ++it) { const int idx = it * 64 + lane, row = idx >> 2, ch = idx & 3; gq[dh][it] = *(const v4u*)(gate_rows + (size_t)row * NQ + dh * 32 + ch * 8); }
    const float lt = half_sum(l_part);
    if (hi == 0) wsf[32 + r32] = lt;
    asm volatile("s_waitcnt lgkmcnt(0)" ::: "memory");
    float rli[16];
#pragma unroll
    for (int r = 0; r < 16; ++r) rli[r] = __builtin_amdgcn_rcpf(wsf[32 + crow(r, hi)]);
#pragma unroll
    for (int dh = 0; dh < 2; ++dh) {
#pragma unroll
        for (int r = 0; r < 16; ++r) stg[crow(r, hi) * 32 + r32] = o[dh][r] * rli[r];
        asm volatile("s_waitcnt lgkmcnt(0)" ::: "memory");
#pragma unroll
        for (int it = 0; it < 2; ++it) { const int idx = it * 64 + lane, row = idx >> 2, ch = idx & 3;
            const f32x4 va = *(const LAS f32x4*)(stg + row * 32 + ch * 8), vb = *(const LAS f32x4*)(stg + row * 32 + ch * 8 + 4);
            const v4u g = gq[dh][it];
            const float g0 = bflo(g.x), g1 = bfhi(g.x), g2 = bflo(g.y), g3 = bfhi(g.y), g4 = bflo(g.z), g5 = bfhi(g.z), g6 = bflo(g.w), g7 = bfhi(g.w);
            v4u w; w.x = pk2(va[0] * g0 * fast_sigmoid(g0), va[1] * g1 * fast_sigmoid(g1)); w.y = pk2(va[2] * g2 * fast_sigmoid(g2), va[3] * g3 * fast_sigmoid(g3));
            w.z = pk2(vb[0] * g4 * fast_sigmoid(g4), vb[1] * g5 * fast_sigmoid(g5)); w.w = pk2(vb[2] * g6 * fast_sigmoid(g6), vb[3] * g7 * fast_sigmoid(g7));
            *(v4u*)(y_rows + (size_t)row * D + dh * 32 + ch * 8) = w; }
        asm volatile("s_waitcnt lgkmcnt(0)" ::: "memory");
    }
}
__device__ __forceinline__ void p2_attn(Frame& F) {
    LAS unsigned char* L = F.lds + RING_OFF;
    const int tid = F.tid, lane = F.lane, wave = F.wave, r32 = lane & 31, hi = lane >> 5;
    LAS float* wsf = (LAS float*)(L + A_WSF) + wave * 64;
    LAS float* stg = (LAS float*)(L + A_STG) + wave * 1024;
    LAS float* sF = (LAS float*)(L + A_F);
    for (int bh = F.vcu; bh < BATCH * BH; bh += F.G) {
        const int b = bh >> 3, h = bh & 7;
        __syncthreads();
        block_cumsum_2048(F.lf + (size_t)b * SEQ * 8 + h, 8, sF, (LAS float*)(L + A_WSF), tid, lane, wave);
        const bf16* Kh = F.QKVG + (size_t)b * SEQ * NQ + C_BK + 64 * h; const bf16* Vh = F.QKVG + (size_t)b * SEQ * NQ + C_BV + 64 * h;
        for (int qb = 0; qb < SEQ / 256; ++qb) {
            const int NT = 4 * (qb + 1), q0 = 256 * qb + 32 * wave;
            const bf16* Qw = F.QKVG + ((size_t)b * SEQ + q0) * NQ + C_BQ + 64 * h;
            bf16x8 qr[4];
#pragma unroll
            for (int d0 = 0; d0 < 4; ++d0) qr[d0] = *(const bf16x8*)(Qw + (size_t)r32 * NQ + d0 * 16 + hi * 8);
            const float fref2 = sF[256 * qb] * LOG2E;
            float m = 0.f, l = 0.f; f32x16 o[2]; o[0] = f32x16{}; o[1] = f32x16{};
            dma_kv_tile(Kh, Vh, L + A_K, L + A_V, wave, lane);
            __syncthreads();
            for (int j = 0; j < NT; ++j) {
                if (j + 1 < NT) dma_kv_tile(Kh + (size_t)(j + 1) * 64 * NQ, Vh + (size_t)(j + 1) * 64 * NQ, L + A_K + ((j + 1) & 1) * 8192, L + A_V + ((j + 1) & 1) * 8192, wave, lane);
                const int jb = j - (NT - 4);
                if (jb <= (wave >> 1)) {
                    const LAS unsigned char* kslot = L + A_K + (j & 1) * 8192; const LAS unsigned char* vslot = L + A_V + (j & 1) * 8192;
                    f32x16 x0, x1; const float cst = fref2 - m;
                    const LAS float* sFt = sF + 64 * j + 4 * hi;
#pragma unroll
                    for (int i = 0; i < 4; ++i) { const f32x4 f0 = *(const LAS f32x4*)(sFt + 8 * i), f1 = *(const LAS f32x4*)(sFt + 32 + 8 * i);
#pragma unroll
                        for (int e = 0; e < 4; ++e) { x0[4 * i + e] = __builtin_fmaf(f0[e], -LOG2E, cst); x1[4 * i + e] = __builtin_fmaf(f1[e], -LOG2E, cst); } }
                    qkt(x0, x1, kslot, qr, r32, hi);
                    if (jb == (wave >> 1)) {
                        const int qrel = 32 * wave + r32 - 64 * jb;
#pragma unroll
                        for (int r = 0; r < 16; ++r) { const int kv = crow(r, hi); if (kv > qrel) x0[r] = -INFINITY; if (kv + 32 > qrel) x1[r] = -INFINITY; }
                    }
                    if (j == 0) softmax_pv<true>(o, m, l, x0, x1, vslot, wsf, lane, r32, hi);
                    else softmax_pv<false>(o, m, l, x0, x1, vslot, wsf, lane, r32, hi);
                }
                __syncthreads();
            }
            attn_epilogue(o, l, wsf, stg, F.QKVG + ((size_t)b * SEQ + q0) * NQ + C_G + 512 + 64 * h, F.R2 + ((size_t)b * SEQ + q0) * D + 512 + 64 * h, lane, r32, hi);
        }
    }
    for (int it0 = F.vcu; it0 < BATCH * AKVH * 4; it0 += F.G) {
        const int pair = it0 >> 2, b = pair >> 1, kvh = pair & 1;
        __syncthreads();
        for (int idx = tid; idx < 4 * 384; idx += NWAVES * 64) { const int g = idx / 384, i = idx % 384, rel = i - 127;
            sF[idx] = (rel >= 0 && rel < WINDOW) ? F.rel_bias[t5_bucket(rel) * AQH + kvh * 4 + g] * LOG2E : -INFINITY; }
        const bf16* Kh = F.QKVG + (size_t)b * SEQ * NQ + C_AK + 64 * kvh; const bf16* Vh = F.QKVG + (size_t)b * SEQ * NQ + C_AV + 64 * kvh;
        for (int u = 0; u < 4; ++u) {
            const int qblk = (it0 & 3) * 4 + u, k0 = 128 * (qblk - 1);
            const int jlo_unit = (qblk == 0) ? 2 : 0;
            __syncthreads();
            for (int jt = jlo_unit; jt < 4; ++jt) dma_kv_tile(Kh + (ptrdiff_t)(k0 + 64 * jt) * NQ, Vh + (ptrdiff_t)(k0 + 64 * jt) * NQ, L + A_K + jt * 8192, L + A_V + jt * 8192, wave, lane);
            __syncthreads();
            for (int pass = 0; pass < 2; ++pass) {
                const int combo = pass * 8 + wave, g = combo >> 2, sb = combo & 3, hq = kvh * 4 + g;
                const int tok0 = 128 * qblk + 32 * sb;
                const bf16* Qw = F.QKVG + ((size_t)b * SEQ + tok0) * NQ + C_AQ + 64 * hq;
                bf16x8 qr[4];
#pragma unroll
                for (int d0 = 0; d0 < 4; ++d0) qr[d0] = *(const bf16x8*)(Qw + (size_t)r32 * NQ + d0 * 16 + hi * 8);
                float m = F.attn_sinks[hq] * LOG2E, l = (hi == 0) ? 1.0f : 0.0f; f32x16 o[2]; o[0] = f32x16{}; o[1] = f32x16{};
                const int jlo = ((sb >> 1) > jlo_unit) ? (sb >> 1) : jlo_unit, jhi = (sb >> 1) + 2;
                for (int jt = jlo; jt <= jhi; ++jt) {
                    const LAS float* tp = sF + g * 384 + (255 + 32 * sb + r32 - 64 * jt - 4 * hi - 59);
                    f32x16 x0, x1;
#pragma unroll
                    for (int r = 0; r < 16; ++r) { x0[r] = tp[59 - ((r & 3) + 8 * (r >> 2))] - m; x1[r] = tp[59 - 32 - ((r & 3) + 8 * (r >> 2))] - m; }
                    qkt(x0, x1, L + A_K + jt * 8192, qr, r32, hi);
                    softmax_pv<false>(o, m, l, x0, x1, L + A_V + jt * 8192, wsf, lane, r32, hi);
                }
                attn_epilogue(o, l, wsf, stg, F.QKVG + ((size_t)b * SEQ + tok0) * NQ + C_G + 64 * hq, F.R2 + ((size_t)b * SEQ + tok0) * D + 64 * hq, lane, r32, hi);
            }
        }
    }
    __syncthreads();
}


__device__ __forceinline__ void stagger_delay(unsigned ticks) {
    if (ticks && ((blockIdx.x >> 3) & 1)) { const unsigned long long t0 = __builtin_amdgcn_s_memrealtime(); while (__builtin_amdgcn_s_memrealtime() - t0 < ticks) __builtin_amdgcn_s_sleep(32); }
}
struct Args { const float* in[20]; float* out; unsigned char* ws; int ph_lo, ph_hi, li, pad; };
__global__ void __launch_bounds__(NWAVES * 64, 2) mk_fwd(Args args) {
    extern __shared__ __attribute__((aligned(16))) unsigned char lds[];
    Frame F;
    F.lds = (LAS unsigned char*)lds;
    F.MISC = (volatile LAS unsigned*)(F.lds + MISC_OFF);
    F.tid = threadIdx.x; F.lane = F.tid & 63; F.wave = __builtin_amdgcn_readfirstlane(F.tid >> 6);
    F.G = gridDim.x; { const int bx = blockIdx.x; F.vcu = (F.G % 8 == 0) ? (bx % 8) * (F.G / 8) + bx / 8 : bx; }
    unsigned char* ws = args.ws;
    F.ctl = (gu32*)(ws + WS_CTL);
    F.x = args.in[0]; F.c = args.in[1]; F.rel_bias = args.in[2]; F.norm_g = args.in[3]; F.ada_w = args.in[4]; F.ada_b = args.in[5]; F.attn_w_in = args.in[6]; F.attn_sinks = args.in[7];
    F.attn_b_f = args.in[8]; F.attn_w_out = args.in[9]; F.lru_w_in = args.in[10]; F.lru_conv_w = args.in[11]; F.lru_conv_b = args.in[12]; F.lru_w_a = args.in[13]; F.lru_b_a = args.in[14];
    F.lru_w_x = args.in[15]; F.lru_b_x = args.in[16]; F.lru_lambda = args.in[17]; F.lru_w_out = args.in[18]; F.final_g = args.in[19]; F.out = args.out;
    F.mod = (float*)(ws + WS_MOD); F.gs = (float*)(ws + WS_GS); F.sw1 = (float*)(ws + WS_SW1); F.part = (float*)(ws + WS_PART); F.part2 = (float*)(ws + WS_PART2); F.lf = (float*)(ws + WS_LF);
    F.x1 = (float*)(ws + WS_X1);
    F.W0T = (bf16*)(ws + WS_W0T); F.WO0T = (bf16*)(ws + WS_WO0T); F.W1T = (bf16*)(ws + WS_W1T); F.WO1T = (bf16*)(ws + WS_WO1T); F.WAT = (bf16*)(ws + WS_WAT); F.WXT = (bf16*)(ws + WS_WXT);
    F.R2 = (bf16*)(ws + WS_R2); F.QKVG = (bf16*)(ws + WS_R1); F.A1 = (bf16*)(ws + WS_A1); F.XG = (bf16*)(ws + WS_XG);
    for (int u = F.tid; u < (LDS_BYTES - LDSCTL_OFF) / 4; u += NWAVES * 64) ((LAS unsigned*)(F.lds + LDSCTL_OFF))[u] = 0u;
    __syncthreads();
    XcdBarrier bar; bar.bar = (unsigned*)(F.ctl + CW_BAR); bar.x = 0; bar.st = nullptr;
    if (N_LAUNCHES == 1) bar = xcd_barrier_post((unsigned*)(F.ctl + CW_BAR), F.MISC + 8);
    const int lo = args.ph_lo, hi = args.ph_hi;
#define IN(k) (lo <= (k) && (k) < hi)
#define SEAM(k) do { if (IN(k) && IN((k) + 1)) xcd_barrier(bar); } while (0)
#define NREP(k) (1 + ((REPEAT_MASK >> (k)) & 1))
#if PHASE_TIMING
#define PSTAMP(k) do { if (blockIdx.x == 0 && F.tid == 0) { const unsigned long long t_ = __builtin_amdgcn_s_memrealtime(); F.ctl[1100 + (k)] = (unsigned)t_; } } while (0)
#else
#define PSTAMP(k) do { } while (0)
#endif
    PSTAMP(0);

    if (IN(0)) { for (int rep = 0; rep < NREP(0); ++rep) { if (rep) xcd_barrier(bar); p0a(F); } SEAM(0); PSTAMP(1); }
    if (IN(1)) { for (int rep = 0; rep < NREP(1); ++rep) { if (rep) xcd_barrier(bar); p0b(F); } SEAM(1); PSTAMP(2); }
    if (IN(2)) {
        pg8::Gemm g{F.R2, F.W0T, M, NQ, D}; pg8::StaticOrder S; S.init(M, NQ, F.G, (int)blockIdx.x); S.rep = NREP(2);
        pg8::EpiQKVG E{F.QKVG, NQ, (1u << 0) | (1u << 1) | (1u << 3) | (1u << 4), QSCALE};
#if GEMM_NAIVE & 1
        naive_gemm<0>(F, F.R2, F.W0T, NQ); (void)g; (void)S; (void)E;
#else
        pg8::gemm_phase<pg8::EpiQKVG, pg8::StaticOrder, true, true>(F.lds + RING_OFF, g, S, E);
#endif
        SEAM(2); PSTAMP(3);
    }
    if (IN(3)) for (int rep = 0; rep < NREP(3); ++rep) { if (rep) xcd_barrier(bar);
#if P2_NAIVE
        p2_naive(F);
#else
        p2_attn(F);
#endif
        SEAM(3); PSTAMP(4);
    }
    if (IN(4)) {
        stagger_delay(STAGGER_P3);
        pg8::Gemm g{F.R2, F.WO0T, M, D, D}; pg8::StaticOrder S; S.init(M, D, F.G, (int)blockIdx.x); S.rep = NREP(4);
        pg8::EpiRes0 E0{F.x, F.x1, F.A1, F.mod + 2048, 3072, F.gs + 32 * 1024, 1024, F.part};
#if GEMM_NAIVE & 2
        naive_gemm<1>(F, F.R2, F.WO0T, D); (void)g; (void)S; (void)E0;
#else
        pg8::gemm_phase<pg8::EpiRes0, pg8::StaticOrder, true, true>(F.lds + RING_OFF, g, S, E0);
#endif
        SEAM(4); PSTAMP(5);
    }
    if (IN(5)) {
        pg8::Gemm g{F.A1, F.W1T, M, NXG, D}; pg8::StaticOrder S; S.init(M, NXG, F.G, (int)blockIdx.x); S.rep = NREP(5);
        pg8::EpiXG E{F.XG, NXG, F.part, F.sw1, 2048, EPS};
#if GEMM_NAIVE & 4
        naive_gemm<2>(F, F.A1, F.W1T, NXG); (void)g; (void)S; (void)E;
#else
        pg8::gemm_phase<pg8::EpiXG, pg8::StaticOrder, true, true>(F.lds + RING_OFF, g, S, E);
#endif
        SEAM(5); PSTAMP(6);
    }
    if (IN(6)) for (int rep = 0; rep < NREP(6); ++rep) { if (rep) xcd_barrier(bar);
#if P5_NAIVE
        p5_naive(F);
#else
        p5_lru(F);
#endif
        SEAM(6); PSTAMP(7);
    }
    if (IN(7)) {
        stagger_delay(STAGGER_P6);
        pg8::Gemm g{F.R2, F.WO1T, M, D, D}; pg8::StaticOrder S; S.init(M, D, F.G, (int)blockIdx.x); S.rep = NREP(7);
        pg8::EpiRes1 E{F.x1, F.out, nullptr, F.mod + (size_t)32 * 3072 + 2048, 3072, nullptr, 0, F.part2};
#if GEMM_NAIVE & 8
        naive_gemm<3>(F, F.R2, F.WO1T, D); (void)g; (void)S; (void)E;
#else
        pg8::gemm_phase<pg8::EpiRes1, pg8::StaticOrder, true, true>(F.lds + RING_OFF, g, S, E);
#endif
        SEAM(7); PSTAMP(8);
    }
    if (IN(8)) { p7(F); }
#undef IN
#undef SEAM
}

extern "C" void kernel_launch(void* const* d_in, const int* in_sizes, int n_in, void* d_out, int out_size, void* d_ws, size_t ws_size, hipStream_t stream) {
    static int grid = 0;
    if (grid == 0) {
        if (n_in != 20 || in_sizes[0] != M * D || out_size != M * D || ws_size < WS_END) { fprintf(stderr, "kernel_launch: unexpected shapes (n_in %d, in0 %d, out %d, ws %zu)\n", n_in, n_in > 0 ? in_sizes[0] : -1, out_size, ws_size); grid = -1; return; }
        int dev = 0, cus = 0;
        if (hipGetDevice(&dev) != hipSuccess || hipDeviceGetAttribute(&cus, hipDeviceAttributeMultiprocessorCount, dev) != hipSuccess) { grid = -1; return; }
        if (hipFuncSetAttribute((const void*)mk_fwd, hipFuncAttributeMaxDynamicSharedMemorySize, LDS_BYTES) != hipSuccess) { fprintf(stderr, "kernel_launch: hipFuncSetAttribute failed\n"); grid = -1; return; }
        (void)hipGetLastError();
        grid = cus;
    }
    if (grid < 0) return;
    if (hipMemsetAsync((char*)d_ws + WS_CTL, 0, CTL_ZERO_BYTES, stream) != hipSuccess) return;
    Args a{};
    for (int i = 0; i < 20; ++i) a.in[i] = (const float*)d_in[i];
    a.out = (float*)d_out; a.ws = (unsigned char*)d_ws;
    for (int li = 0; li < N_LAUNCHES; ++li) {
        a.ph_lo = (N_LAUNCHES == 1) ? 0 : li; a.ph_hi = (N_LAUNCHES == 1) ? N_PHASES : li + 1; a.li = li;
        hipLaunchKernelGGL(mk_fwd, dim3(grid), dim3(NWAVES * 64), LDS_BYTES, stream, a);
    }
}
```
